# Optimizing an MI355X kernel written in HIP

```python
import math
import jax, jax.numpy as jnp
from jax import lax
import numpy as np

D_MODEL = 1024
BATCH = 4
SEQ = 4096
DEPTH = 1
DEC_BATCH = 32
DEC_SEQ = 1
PAST_LEN = 16384
PAGE_SIZE = 128

SSM_WIDTH = D_MODEL
SSM_GROUP = 16
SSM_GROUPS = SSM_WIDTH // SSM_GROUP
SSM_STATE = 64
SSM_CHUNK = 128
DT_MIN = 0.001
DT_MAX = 0.1
HEAD_DIM = 64
HEADS_PER_GROUP = 4
DIL_WINDOWS = (128, 512, 2048)
DIL_RATES = (1, 4, 16)
N_DIL_GROUPS = 3
ATTN_HEADS = N_DIL_GROUPS * HEADS_PER_GROUP
ATTN_WIDTH = ATTN_HEADS * HEAD_DIM
SLOT_WIDTH = HEADS_PER_GROUP * HEAD_DIM
Q_BLOCK = 128
ALIBI_MAX_EXP = 8.0
D_FF = 2816
RMS_EPS = 1e-6
IN_WIDTH = SSM_WIDTH + 3 * ATTN_WIDTH + 2 * D_MODEL

kernel_name = "hybrid_s5_dilated_attn_macaron_step"

F32 = jnp.float32


def _rmsnorm(x, w):
    x32 = x.astype(F32)
    y = x32 * lax.rsqrt(jnp.mean(x32 * x32, axis=-1, keepdims=True) + RMS_EPS)
    return (y * w.astype(F32)).astype(x.dtype)


def _swiglu(h, w_gate, w_up, w_down):
    return (jax.nn.silu(h @ w_gate) * (h @ w_up)) @ w_down


def _cmul(ar, ai, br, bi):
    return ar * br - ai * bi, ar * bi + ai * br


def _scan_op(e1, e2):
    a1r, a1i, b1r, b1i = e1
    a2r, a2i, b2r, b2i = e2
    ar, ai = _cmul(a2r, a2i, a1r, a1i)
    br, bi = _cmul(a2r, a2i, b1r, b1i)
    return ar, ai, br + b2r, bi + b2i


def _s5_discretise(lambda_re, lambda_im, b_re, b_im, log_dt):
    lr = jnp.minimum(lambda_re.astype(F32), -1e-4)
    li = lambda_im.astype(F32)
    dt = jnp.exp(log_dt.astype(F32))[:, None]
    mag = jnp.exp(lr * dt)
    abar_re = mag * jnp.cos(li * dt)
    abar_im = mag * jnp.sin(li * dt)
    nr = abar_re - 1.0
    ni = abar_im
    den = lr * lr + li * li
    fr = (nr * lr + ni * li) / den
    fi = (ni * lr - nr * li) / den
    bbar_re, bbar_im = _cmul(fr[..., None], fi[..., None], b_re.astype(F32), b_im.astype(F32))
    return abar_re, abar_im, bbar_re, bbar_im


def _s5_scan(u, h0_re, h0_im, abar_re, abar_im, bbar_re, bbar_im, c_re, c_im):
    bt, length = u.shape[:2]
    chunk = SSM_CHUNK if length % SSM_CHUNK == 0 else length
    n_chunks = length // chunk
    uc = u.reshape(bt, n_chunks, chunk, SSM_GROUPS, SSM_GROUP).swapaxes(0, 1)
    a_shape = (bt, chunk, SSM_GROUPS, SSM_STATE)
    ar = jnp.broadcast_to(abar_re, a_shape)
    ai = jnp.broadcast_to(abar_im, a_shape)
    c_re32 = c_re.astype(F32)
    c_im32 = c_im.astype(F32)

    def step(carry, u_blk):
        hr, hi = carry
        br = jnp.einsum('btgc,gpc->btgp', u_blk, bbar_re)
        bi = jnp.einsum('btgc,gpc->btgp', u_blk, bbar_im)
        pr, pi, sr, si = lax.associative_scan(_scan_op, (ar, ai, br, bi), axis=1)
        xr = pr * hr[:, None] - pi * hi[:, None] + sr
        xi = pr * hi[:, None] + pi * hr[:, None] + si
        y = jnp.einsum('btgp,gkp->btgk', xr, c_re32) - jnp.einsum('btgp,gkp->btgk', xi, c_im32)
        return (xr[:, -1], xi[:, -1]), y

    (hr, hi), ys = lax.scan(step, (h0_re, h0_im), uc)
    return ys.swapaxes(0, 1).reshape(bt, length, SSM_WIDTH), hr, hi


def _dilated_attention(q, kv, q_pos, window, dilation, slopes):
    dist = jnp.arange(window // dilation + 1, dtype=jnp.int32) * dilation
    penalty = slopes[:, None] * dist.astype(F32)[None, :]

    def attend(q_blk, pos_blk):
        idx = pos_blk[:, None] - dist[None, :]
        valid = idx >= 0
        kv_g = jnp.take(kv, jnp.maximum(idx, 0), axis=1)
        s = jnp.einsum('bqhd,bqkhd->bhqk', q_blk, kv_g[:, :, :, 0], preferred_element_type=F32)
        s = s - penalty[None, :, None, :]
        s = jnp.where(valid[None, None], s, -jnp.inf)
        m = jnp.max(s, axis=-1, keepdims=True)
        p = jnp.exp(s - m)
        den = jnp.sum(p, axis=-1, keepdims=True)
        o = jnp.einsum('bhqk,bqkhd->bqhd', (p / den).astype(kv.dtype), kv_g[:, :, :, 1])
        lse = (m + jnp.log(den))[..., 0].transpose(0, 2, 1)
        return o, lse

    bt, lq = q.shape[:2]
    if lq % Q_BLOCK == 0 and lq > Q_BLOCK:
        nb = lq // Q_BLOCK
        qb = q.reshape(bt, nb, Q_BLOCK, HEADS_PER_GROUP, HEAD_DIM).swapaxes(0, 1)
        pb = q_pos.reshape(nb, Q_BLOCK)
        o, lse = lax.map(lambda a: attend(a[0], a[1]), (qb, pb))
        o = o.swapaxes(0, 1).reshape(bt, lq, HEADS_PER_GROUP, HEAD_DIM)
        lse = lse.swapaxes(0, 1).reshape(bt, lq, HEADS_PER_GROUP)
        return o, lse
    return attend(q, q_pos)


def _layer(x, h0_re, h0_im, kv_past, keep_rows, p, slopes):
    bt, length = x.shape[:2]
    x = x + 0.5 * _swiglu(_rmsnorm(x, p['ffn1_norm']), p['ffn1_w_gate'], p['ffn1_w_up'], p['ffn1_w_down'])
    h = _rmsnorm(x, p['mix_norm'])
    z = h @ p['w_in']
    cuts = [SSM_WIDTH, SSM_WIDTH + ATTN_WIDTH, SSM_WIDTH + 2 * ATTN_WIDTH,
            SSM_WIDTH + 3 * ATTN_WIDTH, SSM_WIDTH + 3 * ATTN_WIDTH + D_MODEL]
    u_a, q, k, v, g_a, g_b = jnp.split(z, cuts, axis=-1)

    abar_re, abar_im, bbar_re, bbar_im = _s5_discretise(
        p['ssm_lambda_re'], p['ssm_lambda_im'], p['ssm_b_re'], p['ssm_b_im'], p['ssm_log_dt'])
    u32 = u_a.astype(F32)
    y_ssm, hr, hi = _s5_scan(u32, h0_re.astype(F32), h0_im.astype(F32),
                             abar_re, abar_im, bbar_re, bbar_im, p['ssm_c_re'], p['ssm_c_im'])
    y_ssm = jax.nn.gelu(y_ssm + p['ssm_d'].astype(F32) * u32).astype(x.dtype)
    y_a = y_ssm * jax.nn.sigmoid(y_ssm @ p['w_glu'])

    hs = (bt, length, N_DIL_GROUPS, HEADS_PER_GROUP, HEAD_DIM)
    q = _rmsnorm(q.reshape(hs), p['q_gain']) * (HEAD_DIM ** -0.5)
    k = _rmsnorm(k.reshape(hs), p['k_gain'])
    kv_new = jnp.stack([k, v.reshape(hs)], axis=3)
    outs, lses, new_kv = [], [], []
    for g in range(N_DIL_GROUPS):
        kv_g = kv_new[:, :, g]
        if kv_past is None:
            kv_all = kv_g
            offset = 0
        else:
            kv_all = jnp.concatenate([kv_past[g].astype(kv_g.dtype), kv_g], axis=1)
            offset = kv_past[g].shape[1]
        pos = offset + jnp.arange(length, dtype=jnp.int32)
        o, lse = _dilated_attention(q[:, :, g], kv_all, pos, DIL_WINDOWS[g], DIL_RATES[g], slopes[g])
        outs.append(o)
        lses.append(lse)
        new_kv.append(kv_all[:, kv_all.shape[1] - keep_rows[g]:])
    mix_w = jax.nn.softmax(jnp.stack(lses, axis=0), axis=0)
    o_b = jnp.sum(mix_w[..., None] * jnp.stack(outs, axis=0).astype(F32), axis=0)
    o_b = o_b.astype(x.dtype).reshape(bt, length, SLOT_WIDTH)

    merged = jax.nn.sigmoid(g_a) * (y_a @ p['w_proj_a']) + jax.nn.sigmoid(g_b) * (o_b @ p['w_proj_b'])
    x = x + merged @ p['w_out']
    x = x + 0.5 * _swiglu(_rmsnorm(x, p['ffn2_norm']), p['ffn2_w_gate'], p['ffn2_w_up'], p['ffn2_w_down'])
    return x, hr.astype(h0_re.dtype), hi.astype(h0_im.dtype), new_kv


def setup_inputs(seed: int = 0) -> dict:
    key = jax.random.key(seed)
    ks = iter(jax.random.split(key, 40))
    nrm = lambda shape, s: jax.random.normal(next(ks), shape, F32) * s
    L = DEPTH
    inp = {}
    inp['x_prompt'] = nrm((BATCH, SEQ, D_MODEL), 1.0)
    inp['x_sample'] = nrm((DEC_BATCH, DEC_SEQ, D_MODEL), 1.0)
    inp['state_ssm_re'] = nrm((L, DEC_BATCH, SSM_GROUPS, SSM_STATE), 0.5)
    inp['state_ssm_im'] = nrm((L, DEC_BATCH, SSM_GROUPS, SSM_STATE), 0.5)
    for w in DIL_WINDOWS:
        inp['cache_kv_w%d' % w] = nrm((L, DEC_BATCH, min(w, PAST_LEN), 2, HEADS_PER_GROUP, HEAD_DIM), 1.0)
    inp['ffn1_norm'] = 1.0 + nrm((L, D_MODEL), 0.02)
    inp['ffn1_w_gate'] = nrm((L, D_MODEL, D_FF), D_MODEL ** -0.5)
    inp['ffn1_w_up'] = nrm((L, D_MODEL, D_FF), D_MODEL ** -0.5)
    inp['ffn1_w_down'] = nrm((L, D_FF, D_MODEL), D_FF ** -0.5)
    inp['mix_norm'] = 1.0 + nrm((L, D_MODEL), 0.02)
    inp['w_in'] = nrm((L, D_MODEL, IN_WIDTH), D_MODEL ** -0.5)
    inp['ssm_lambda_re'] = -0.5 + nrm((L, SSM_GROUPS, SSM_STATE), 0.01)
    inp['ssm_lambda_im'] = jnp.pi * jnp.arange(SSM_STATE, dtype=F32) + nrm((L, SSM_GROUPS, SSM_STATE), 0.01)
    inp['ssm_b_re'] = nrm((L, SSM_GROUPS, SSM_STATE, SSM_GROUP), (2 * SSM_GROUP) ** -0.5)
    inp['ssm_b_im'] = nrm((L, SSM_GROUPS, SSM_STATE, SSM_GROUP), (2 * SSM_GROUP) ** -0.5)
    inp['ssm_c_re'] = nrm((L, SSM_GROUPS, SSM_GROUP, SSM_STATE), SSM_STATE ** -0.5)
    inp['ssm_c_im'] = nrm((L, SSM_GROUPS, SSM_GROUP, SSM_STATE), SSM_STATE ** -0.5)
    inp['ssm_d'] = nrm((L, SSM_WIDTH), 1.0)
    inp['ssm_log_dt'] = jax.random.uniform(next(ks), (L, SSM_GROUPS), F32,
                                           minval=math.log(DT_MIN), maxval=math.log(DT_MAX))
    inp['w_glu'] = nrm((L, SSM_WIDTH, SSM_WIDTH), SSM_WIDTH ** -0.5)
    inp['q_gain'] = 1.0 + nrm((L, HEAD_DIM), 0.02)
    inp['k_gain'] = 1.0 + nrm((L, HEAD_DIM), 0.02)
    inp['w_proj_a'] = nrm((L, SSM_WIDTH, D_MODEL), SSM_WIDTH ** -0.5)
    inp['w_proj_b'] = nrm((L, SLOT_WIDTH, D_MODEL), SLOT_WIDTH ** -0.5)
    inp['w_out'] = nrm((L, D_MODEL, D_MODEL), D_MODEL ** -0.5)
    inp['ffn2_norm'] = 1.0 + nrm((L, D_MODEL), 0.02)
    inp['ffn2_w_gate'] = nrm((L, D_MODEL, D_FF), D_MODEL ** -0.5)
    inp['ffn2_w_up'] = nrm((L, D_MODEL, D_FF), D_MODEL ** -0.5)
    inp['ffn2_w_down'] = nrm((L, D_FF, D_MODEL), D_FF ** -0.5)
    return inp


def reference(x_prompt, x_sample, state_ssm_re, state_ssm_im, cache_kv_w128, cache_kv_w512, cache_kv_w2048,
              ffn1_norm, ffn1_w_gate, ffn1_w_up, ffn1_w_down, mix_norm, w_in,
              ssm_lambda_re, ssm_lambda_im, ssm_b_re, ssm_b_im, ssm_c_re, ssm_c_im, ssm_d, ssm_log_dt,
              w_glu, q_gain, k_gain, w_proj_a, w_proj_b, w_out,
              ffn2_norm, ffn2_w_gate, ffn2_w_up, ffn2_w_down):
    slopes = jnp.exp2(-ALIBI_MAX_EXP * jnp.arange(1, ATTN_HEADS + 1, dtype=F32) / ATTN_HEADS)
    slopes = slopes.reshape(N_DIL_GROUPS, HEADS_PER_GROUP)
    yp, ys = x_prompt, x_sample
    p_re, p_im, s_re, s_im = [], [], [], []
    p_kv = [[], [], []]
    s_kv = [[], [], []]
    for l in range(DEPTH):
        p = dict(ffn1_norm=ffn1_norm[l], ffn1_w_gate=ffn1_w_gate[l], ffn1_w_up=ffn1_w_up[l],
                 ffn1_w_down=ffn1_w_down[l], mix_norm=mix_norm[l], w_in=w_in[l],
                 ssm_lambda_re=ssm_lambda_re[l], ssm_lambda_im=ssm_lambda_im[l],
                 ssm_b_re=ssm_b_re[l], ssm_b_im=ssm_b_im[l], ssm_c_re=ssm_c_re[l], ssm_c_im=ssm_c_im[l],
                 ssm_d=ssm_d[l], ssm_log_dt=ssm_log_dt[l], w_glu=w_glu[l], q_gain=q_gain[l], k_gain=k_gain[l],
                 w_proj_a=w_proj_a[l], w_proj_b=w_proj_b[l], w_out=w_out[l],
                 ffn2_norm=ffn2_norm[l], ffn2_w_gate=ffn2_w_gate[l], ffn2_w_up=ffn2_w_up[l],
                 ffn2_w_down=ffn2_w_down[l])
        h0 = jnp.zeros((yp.shape[0], SSM_GROUPS, SSM_STATE), yp.dtype)
        keep_p = tuple(min(w, yp.shape[1]) for w in DIL_WINDOWS)
        yp, hr, hi, kvp = _layer(yp, h0, h0, None, keep_p, p, slopes)
        past = (cache_kv_w128[l], cache_kv_w512[l], cache_kv_w2048[l])
        keep_s = tuple(c.shape[1] for c in past)
        ys, sr, si, kvs = _layer(ys, state_ssm_re[l], state_ssm_im[l], past, keep_s, p, slopes)
        p_re.append(hr)
        p_im.append(hi)
        s_re.append(sr)
        s_im.append(si)
        for g in range(N_DIL_GROUPS):
            p_kv[g].append(kvp[g])
            s_kv[g].append(kvs[g])
    return (yp, ys,
            jnp.stack(p_re), jnp.stack(p_im),
            jnp.stack(p_kv[0]), jnp.stack(p_kv[1]), jnp.stack(p_kv[2]),
            jnp.stack(s_re), jnp.stack(s_im),
            jnp.stack(s_kv[0]), jnp.stack(s_kv[1]), jnp.stack(s_kv[2]))
```

```cpp
#include <hip/hip_runtime.h>
#include <cstdio>
#include <cstdint>

#define LAS __attribute__((address_space(3)))
#define GAS __attribute__((address_space(1)))
typedef unsigned short bf16;
typedef short bf16x8 __attribute__((ext_vector_type(8)));
typedef short s16x4 __attribute__((ext_vector_type(4)));
typedef float f32x2 __attribute__((ext_vector_type(2)));
typedef float f32x4 __attribute__((ext_vector_type(4)));
typedef float f32x16 __attribute__((ext_vector_type(16)));
typedef unsigned u32x2 __attribute__((ext_vector_type(2)));
typedef unsigned u32x4 __attribute__((ext_vector_type(4)));

constexpr int DM = 1024, NBATCH = 4, SEQ = 4096, MPR = NBATCH * SEQ, NSMP = 32, MP = MPR + 256, FF = 2816, NIN = 5376;
constexpr int NG = 64, GC = 16, NPS = 64, CH = 32, NCH = SEQ / CH;
constexpr int HD = 64, AW = 768, SW = 256;
constexpr float RMS_EPS = 1e-6f;
constexpr int NWAVES = 8;

constexpr size_t O_YP = 0, O_YS = O_YP + (size_t)MPR * DM, O_PSR = O_YS + (size_t)NSMP * DM, O_PSI = O_PSR + 4 * 64 * 64,
                 O_PKV0 = O_PSI + 4 * 64 * 64, O_PKV1 = O_PKV0 + (size_t)4 * 128 * 512, O_PKV2 = O_PKV1 + (size_t)4 * 512 * 512,
                 O_SSR = O_PKV2 + (size_t)4 * 2048 * 512, O_SSI = O_SSR + 32 * 64 * 64, O_SKV0 = O_SSI + 32 * 64 * 64,
                 O_SKV1 = O_SKV0 + (size_t)32 * 128 * 512, O_SKV2 = O_SKV1 + (size_t)32 * 512 * 512, O_END = O_SKV2 + (size_t)32 * 2048 * 512;

constexpr size_t MiB = 1u << 20;
constexpr size_t WS_CTL = 0, CTL_ZERO_BYTES = 1 * MiB;
constexpr size_t WS_WGU1 = 1 * MiB;
constexpr size_t WS_WD1  = 12 * MiB;
constexpr size_t WS_WIN  = 18 * MiB;
constexpr size_t WS_WGLU = 29 * MiB, WS_WPA = 31 * MiB, WS_WOUT = 33 * MiB;
constexpr size_t WS_WPB  = 35 * MiB;
constexpr size_t WS_WGU2 = 36 * MiB, WS_WD2 = 47 * MiB;
constexpr size_t WS_KT   = 53 * MiB;
constexpr size_t KT_STRIDE = 47 * 512;
constexpr size_t WS_BH   = 55 * MiB;
constexpr size_t WS_W1T  = 63 * MiB;
constexpr size_t WS_SSMP = 72 * MiB;
constexpr size_t SSMP_A32 = 0, SSMP_A1 = 64 * 64 * 2 * 4, SSMP_BB = 2 * 64 * 64 * 2 * 4;
constexpr size_t WS_XBF  = 73 * MiB;
constexpr size_t WS_SS0  = 106 * MiB;
constexpr size_t WS_SSP  = 107 * MiB;
constexpr size_t WS_HID  = 109 * MiB;
constexpr size_t WS_OG   = WS_HID;
constexpr size_t WS_LSE  = WS_HID + 48 * MiB;
constexpr size_t WS_YA   = WS_HID + 49 * MiB;
constexpr size_t WS_XR   = 199 * MiB;
constexpr size_t WS_U    = 264 * MiB;
constexpr size_t WS_HS   = 296 * MiB;
constexpr size_t WS_SST  = 304 * MiB;
constexpr size_t WS_Q    = 320 * MiB, WS_K = 345 * MiB, WS_V = 370 * MiB;
constexpr size_t WS_TB   = WS_Q;
constexpr size_t WS_GA   = 395 * MiB, WS_GB = 428 * MiB;
constexpr size_t WS_YSM  = 461 * MiB;
constexpr size_t WS_OB   = 494 * MiB;
constexpr size_t WS_US   = 503 * MiB;
constexpr size_t WS_END  = 504 * MiB;
constexpr size_t WS_SSPS = WS_US + 384 * 1024;
static_assert(WS_U + (size_t)NG * 512 * 512 * 2 <= WS_HS && WS_HS + (size_t)NG * 512 * 128 * 2 <= WS_SST && WS_SST + (size_t)NG * 512 * 128 * 4 <= WS_Q, "ws map 0");
static_assert(WS_BH + (size_t)NG * 512 * 128 * 2 <= WS_W1T && WS_OG + (size_t)3 * MPR * SW * 4 <= WS_LSE && WS_LSE + (size_t)3 * MPR * 16 <= WS_YA && WS_US + (size_t)NSMP * DM * 4 <= WS_END, "ws map 00");
static_assert(WS_HID + (size_t)MP * FF * 2 <= WS_XR && WS_YA + (size_t)MP * DM * 2 <= WS_XR && WS_XR + (size_t)MP * DM * 4 <= WS_U, "ws map");
static_assert(WS_Q + (size_t)MP * AW * 2 <= WS_K && WS_V + (size_t)MP * AW * 2 <= WS_GA && WS_TB + (size_t)MP * DM * 2 <= WS_V, "ws map 2");
static_assert(WS_GA + (size_t)MP * DM * 2 <= WS_GB && WS_GB + (size_t)MP * DM * 2 <= WS_YSM && WS_YSM + (size_t)MP * DM * 2 <= WS_OB && WS_OB + (size_t)MP * SW * 2 <= WS_US, "ws map 3");
static_assert(WS_XBF + (size_t)MP * DM * 2 <= WS_SS0 && WS_SS0 + (size_t)MP * 4 <= WS_SSP && WS_SSP + (size_t)MP * 64 <= WS_HID, "ws map 4");
static_assert(WS_KT + 64 * KT_STRIDE <= WS_BH && WS_W1T + 64 * 128 * 1024 + 256 * 1024 <= WS_SSMP, "ws map 5");

constexpr int CW_BAR = 4096;

constexpr int RING_BYTES = 131072;
constexpr int LDSCTL_OFF = RING_BYTES, MISC_OFF = LDSCTL_OFF + 320;
constexpr int LDS_BYTES = 147456;

typedef GAS unsigned gu32;
#define LDS_WAIT() asm volatile("s_waitcnt lgkmcnt(0)" ::: "memory")
#define VM_WAIT() asm volatile("s_waitcnt vmcnt(0)" ::: "memory")
__device__ __forceinline__ unsigned f2bf(float f) { unsigned u = __builtin_bit_cast(unsigned, f); return (u + 0x7fffu + ((u >> 16) & 1u)) >> 16; }
__device__ __forceinline__ unsigned pk2(float lo, float hi) { return f2bf(lo) | (f2bf(hi) << 16); }
__device__ __forceinline__ float bf2f(unsigned short b) { return __builtin_bit_cast(float, (unsigned)b << 16); }
__device__ __forceinline__ float bflo(unsigned w) { return __builtin_bit_cast(float, w << 16); }
__device__ __forceinline__ float bfhi(unsigned w) { return __builtin_bit_cast(float, w & 0xffff0000u); }
typedef __bf16 bf16x2_t __attribute__((ext_vector_type(2)));
__device__ __forceinline__ unsigned cvt_pk_bf16(float lo, float hi) { const f32x2 v = {lo, hi}; const bf16x2_t b = __builtin_convertvector(v, bf16x2_t); return __builtin_bit_cast(unsigned, b); }
__device__ __forceinline__ float fast_rcp(float x) { return __builtin_amdgcn_rcpf(x); }
__device__ __forceinline__ float fast_exp2(float x) { return __builtin_amdgcn_exp2f(x); }
__device__ __forceinline__ float sigmoidf_(float x) { return fast_rcp(1.0f + fast_exp2(-1.4426950408889634f * x)); }
__device__ __forceinline__ float gelu_tanh(float x) {
    const float u = 0.7978845608028654f * (x + 0.044715f * x * x * x);
    return x * sigmoidf_(2.0f * u);
}

#define XB_TMO      128
#define XB_XCNT(j)  (256  + 64 * (j))
#define XB_XSUB(j)  (1280 + 64 * (j))
#define XB_XGEN(j)  (2304 + 64 * (j))
#define XB_TOP      3328
#define XB_TOPGEN   3392
#define XCD_BAR_WORDS 3456
#define XB_SPIN_CAP (1u << 18)
__device__ __forceinline__ unsigned xb_ld(unsigned* p)              { return __hip_atomic_load(p, __ATOMIC_RELAXED, __HIP_MEMORY_SCOPE_AGENT); }
__device__ __forceinline__ unsigned xb_add(unsigned* p, unsigned v) { return __hip_atomic_fetch_add(p, v, __ATOMIC_RELAXED, __HIP_MEMORY_SCOPE_AGENT); }
__device__ __forceinline__ unsigned xb_xcc_id() { return (unsigned)__builtin_amdgcn_s_getreg((3 << 11) | 20) & 0xFu; }
#define XB_SPIN(cond, bar) do { unsigned _sp = 0; while (cond) { __builtin_amdgcn_s_sleep(1); \
    if ((++_sp & 255u) == 0u) { if (xb_ld(&(bar)[XB_TMO])) break; if (_sp > XB_SPIN_CAP) { atomicAdd(&(bar)[XB_TMO], 1u); break; } } } } while (0)
struct XcdBarrier { unsigned* bar; unsigned x; volatile LAS unsigned* st; };
__device__ __forceinline__ XcdBarrier xcd_barrier_post(unsigned* bar, volatile LAS unsigned* st) {
    XcdBarrier b; b.bar = bar; b.x = xb_xcc_id(); b.st = st;
    if (threadIdx.x == 0) (void)xb_add(&bar[XB_XCNT(b.x)], 1u);
    return b;
}
__device__ __forceinline__ void xcd_barrier_complete(unsigned* bar, unsigned x, unsigned& nloc, unsigned& nx) {
    const unsigned G = gridDim.x * gridDim.y * gridDim.z;
    unsigned sum, cnt, mine, sp = 0u;
    for (;;) {
        sum = 0u; cnt = 0u; mine = 0u;
#pragma unroll
        for (unsigned j = 0; j < 16; ++j) { const unsigned c = xb_ld(&bar[XB_XCNT(j)]); sum += c; cnt += (c > 0u) ? 1u : 0u; mine = (j == x) ? c : mine; }
        if (sum == G) break;
        __builtin_amdgcn_s_sleep(1);
        if ((++sp & 255u) == 0u) { if (xb_ld(&bar[XB_TMO])) break; if (sp > XB_SPIN_CAP) { atomicAdd(&bar[XB_TMO], 1u); break; } }
    }
    nloc = mine > 0u ? mine : 1u; nx = cnt > 0u ? cnt : 1u;
}
__device__ __forceinline__ void xcd_barrier(const XcdBarrier& b) {
    asm volatile("s_waitcnt vmcnt(0)" ::: "memory");
    __syncthreads();
    if (threadIdx.x == 0) {
        unsigned* bar = b.bar;
        __builtin_amdgcn_s_waitcnt(0);
        unsigned nloc = b.st[0], nx = b.st[1];
        if (nloc == 0u) { xcd_barrier_complete(bar, b.x, nloc, nx); b.st[0] = nloc; b.st[1] = nx; }
        const unsigned old = xb_add(&bar[XB_XSUB(b.x)], 1u);
        const unsigned gen = old / nloc;
        if (old + 1u == (gen + 1u) * nloc) {
            __builtin_amdgcn_fence(__ATOMIC_RELEASE, "agent");
            asm volatile("s_waitcnt vmcnt(0)" ::: "memory");
            const unsigned og = xb_add(&bar[XB_TOP], 1u);
            const unsigned tg = og / nx;
            if (og + 1u == (tg + 1u) * nx) xb_add(&bar[XB_TOPGEN], 1u);
            else XB_SPIN(xb_ld(&bar[XB_TOPGEN]) == tg, bar);
            __builtin_amdgcn_fence(__ATOMIC_ACQUIRE, "agent");
            xb_add(&bar[XB_XGEN(b.x)], 1u);
            asm volatile("s_waitcnt vmcnt(0)" ::: "memory");
        } else {
            XB_SPIN(xb_ld(&bar[XB_XGEN(b.x)]) == gen, bar);
            __builtin_amdgcn_fence(__ATOMIC_ACQUIRE, "agent");
            asm volatile("s_waitcnt vmcnt(0)" ::: "memory");
        }
    }
    __syncthreads();
}

namespace ge {
constexpr int BM = 256, BK = 64, HALF = 128, HTB = HALF * BK * 2;
__host__ __device__ __forceinline__ int lds_byte(int r, int c) { const int st = (r >> 4) * 2 + (c >> 5), rr = r & 15, cc = c & 31, ob = rr * 64 + cc * 2; return st * 1024 + (ob ^ (((ob >> 9) & 1) << 5)); }
__host__ __device__ __forceinline__ void stage_rc(int b, int& R, int& C) { const int st = b / 1024, sb = b % 1024, swz = sb ^ (((sb >> 9) & 1) << 5); R = (st >> 1) * 16 + swz / 64; C = (st & 1) * 32 + (swz % 64) / 2; }
__host__ __device__ __forceinline__ int perm32(int rho) { const int n = rho >> 4, i = rho & 15; return 8 * (i >> 2) + 4 * n + (i & 3); }

struct Seg { const char* A; const char* B; int nt, flags, geo, pm, pn, aux, bjmask; };
struct GeoDesc { int lda, ldb, toep; };

template <class Epi, class Sched, int NGEO>
__device__ __forceinline__ void gemm_phase(LAS unsigned char* lds, const Sched& S, const Epi& E, const GeoDesc (&gd)[NGEO]) {
    const int tid = threadIdx.x, wid = __builtin_amdgcn_readfirstlane(tid >> 6), lane = tid & 63, wr = wid >> 2, wc = wid & 3, fr = lane & 15, fq = lane >> 4;
    unsigned vA[NGEO][2], vB[NGEO][2]; int kstB[NGEO], hsA[NGEO], hsB[NGEO];
#pragma unroll
    for (int g = 0; g < NGEO; ++g) {
#pragma unroll
        for (int i = 0; i < 2; ++i) { int R, C; stage_rc(tid * 16 + i * 8192, R, C); const int Rb = (R & ~31) + perm32(R & 31);
            vA[g][i] = (unsigned)(R * gd[g].lda + C * 2);
            vB[g][i] = gd[g].toep ? (unsigned)((((Rb >> 4) - (C >> 4) + 15) * 256 + (Rb & 15) * 16 + (C & 15)) * 2) : (unsigned)(Rb * gd[g].ldb + C * 2); }
        kstB[g] = gd[g].toep ? -2048 : 128; hsA[g] = HALF * gd[g].lda; hsB[g] = gd[g].toep ? 4096 : HALF * gd[g].ldb;
    }
    const unsigned ldsw = (unsigned)wid * 1024u;
    const int aoff = lds_byte(wr * 64 + fr, fq * 8), boff = lds_byte(wc * 32 + fr, fq * 8);
#define GE_SA(b, h) (((b) * 2 + (h)) * HTB)
#define GE_SB(b, h) ((4 + (b) * 2 + (h)) * HTB)
#define GE_VA(g, i) (NGEO == 1 ? vA[0][i] : ((g) ? vA[NGEO - 1][i] : vA[0][i]))
#define GE_VB(g, i) (NGEO == 1 ? vB[0][i] : ((g) ? vB[NGEO - 1][i] : vB[0][i]))
#define GE_KSB(g) (NGEO == 1 ? kstB[0] : ((g) ? kstB[NGEO - 1] : kstB[0]))
#define GE_HSA(g) (NGEO == 1 ? hsA[0] : ((g) ? hsA[NGEO - 1] : hsA[0]))
#define GE_HSB(g) (NGEO == 1 ? hsB[0] : ((g) ? hsB[NGEO - 1] : hsB[0]))
#define GE_STAGE(bufoff, gbase, v0, v1) do { \
        __builtin_amdgcn_global_load_lds((const unsigned*)((const char*)(gbase) + (v0)), (LAS unsigned*)(lds + (bufoff) + ldsw), 16, 0, 0); \
        __builtin_amdgcn_global_load_lds((const unsigned*)((const char*)(gbase) + (v1)), (LAS unsigned*)(lds + (bufoff) + ldsw + 8192), 16, 0, 0); } while (0)
#define GE_STAGE_A(bufoff, gbase, g) GE_STAGE(bufoff, gbase, GE_VA(g, 0), GE_VA(g, 1))
#define GE_STAGE_B(bufoff, gbase, g) GE_STAGE(bufoff, gbase, GE_VB(g, 0), GE_VB(g, 1))
#define GE_LDA(dst, b, h) do { _Pragma("unroll") for (int m = 0; m < 4; ++m) _Pragma("unroll") for (int k = 0; k < 2; ++k) dst[m][k] = *(const LAS bf16x8*)(lds + GE_SA(b, h) + aoff + m * 2048 + k * 1024); } while (0)
#define GE_LDB(dst, b, h) do { _Pragma("unroll") for (int n = 0; n < 2; ++n) _Pragma("unroll") for (int k = 0; k < 2; ++k) dst[n][k] = *(const LAS bf16x8*)(lds + GE_SB(b, h) + boff + n * 2048 + k * 1024); } while (0)
#define GE_MMA(ai, bj, At, Bt) do { __builtin_amdgcn_s_setprio(1); _Pragma("unroll") for (int m = 0; m < 4; ++m) _Pragma("unroll") for (int n = 0; n < 2; ++n) _Pragma("unroll") for (int k = 0; k < 2; ++k) \
        acc[ai][bj][m][n] = __builtin_amdgcn_mfma_f32_16x16x32_bf16(Bt[n][k], At[m][k], acc[ai][bj][m][n], 0, 0, 0); __builtin_amdgcn_s_setprio(0); } while (0)
#define GE_WAIT_V(n) asm volatile("s_waitcnt vmcnt(" #n ")" ::: "memory")
#define GE_WAIT_L(n) asm volatile("s_waitcnt lgkmcnt(" #n ")" ::: "memory")
#define GE_BAR __builtin_amdgcn_s_barrier()
#define GE_SCHED __builtin_amdgcn_sched_barrier(0)
    Seg cur, nxt; int si = 0;
    if (!S.seg(0, cur)) return;
    f32x4 acc[2][2][4][2];
#pragma unroll
    for (int a = 0; a < 2; ++a)
#pragma unroll
        for (int b = 0; b < 2; ++b)
#pragma unroll
            for (int m = 0; m < 4; ++m)
#pragma unroll
                for (int n = 0; n < 2; ++n) acc[a][b][m][n] = (f32x4){0.f, 0.f, 0.f, 0.f};
    bf16x8 At[4][2], B0[2][2], B1[2][2];
    const char* cA = cur.A; const char* cB = cur.B; int cg = cur.geo;
    {
        GE_STAGE_B(GE_SB(0, 0), cB, cg); GE_STAGE_B(GE_SB(0, 1), cB + GE_HSB(cg), cg); GE_STAGE_A(GE_SA(0, 0), cA, cg); GE_STAGE_A(GE_SA(0, 1), cA + GE_HSA(cg), cg);
        if (wr == 1) GE_BAR;
        GE_WAIT_V(2); GE_BAR;
        GE_STAGE_B(GE_SB(1, 0), cB + GE_KSB(cg), cg); GE_STAGE_A(GE_SA(1, 0), cA + 128, cg); GE_STAGE_B(GE_SB(1, 1), cB + GE_HSB(cg) + GE_KSB(cg), cg);
        GE_WAIT_V(6); GE_BAR;
    }
    for (;;) {
        const bool has_next = S.seg(si + 1, nxt);
        const char* nA = has_next ? nxt.A : cA; const char* nB = has_next ? nxt.B : cB; const int ng = has_next ? nxt.geo : cg;
        const int nt = cur.nt;
        for (int t = 0; t < nt; t += 2) {
            const bool last = (t == nt - 2);
            const int g2 = last ? ng : cg;
            const char* a1 = cA + (size_t)(t + 1) * 128;
            const char* a2 = last ? nA : cA + (size_t)(t + 2) * 128;
            const char* b2 = last ? nB : cB + (long)(t + 2) * GE_KSB(cg);
            const char* a3 = a2 + 128; const char* b3 = b2 + GE_KSB(g2);
            GE_LDB(B0, 0, 0); GE_LDB(B1, 0, 1); GE_SCHED; GE_LDA(At, 0, 0); GE_STAGE_A(GE_SA(1, 1), a1 + GE_HSA(cg), cg);
            GE_WAIT_V(8); GE_WAIT_L(0); GE_BAR; GE_MMA(0, 0, At, B0); GE_MMA(0, 1, At, B1); GE_BAR; GE_SCHED;
            GE_LDA(At, 0, 1); GE_STAGE_B(GE_SB(0, 0), b2, g2); GE_STAGE_B(GE_SB(0, 1), b2 + GE_HSB(g2), g2); GE_STAGE_A(GE_SA(0, 0), a2, g2);
            GE_WAIT_V(8); GE_WAIT_L(0); GE_BAR; GE_MMA(1, 0, At, B0); GE_MMA(1, 1, At, B1); GE_BAR; GE_SCHED;
            GE_LDB(B0, 1, 0); GE_LDB(B1, 1, 1); GE_SCHED; GE_LDA(At, 1, 0); GE_STAGE_A(GE_SA(0, 1), a2 + GE_HSA(g2), g2);
            GE_WAIT_V(8); GE_WAIT_L(0); GE_BAR; GE_MMA(0, 0, At, B0); GE_MMA(0, 1, At, B1); GE_BAR; GE_SCHED;
            GE_LDA(At, 1, 1); GE_STAGE_B(GE_SB(1, 0), b3, g2); GE_STAGE_B(GE_SB(1, 1), b3 + GE_HSB(g2), g2); GE_STAGE_A(GE_SA(1, 0), a3, g2);
            GE_WAIT_V(8); GE_WAIT_L(0); GE_BAR; GE_MMA(1, 0, At, B0); GE_MMA(1, 1, At, B1); GE_BAR; GE_SCHED;
        }
        const bool epi = (cur.flags & 1) != 0;
        if (epi) {
            if (wr == 0) GE_BAR;
            E.template run<2, 4>(acc, cur, wr, wc, fr, fq);
        }
        if (!has_next) break;
        if (epi) {
#pragma unroll
            for (int a = 0; a < 2; ++a)
#pragma unroll
                for (int b = 0; b < 2; ++b)
#pragma unroll
                    for (int m = 0; m < 4; ++m)
#pragma unroll
                        for (int n = 0; n < 2; ++n) acc[a][b][m][n] = (f32x4){0.f, 0.f, 0.f, 0.f};
        }
        cur = nxt; cA = nA; cB = nB; cg = ng; ++si;
        if (epi) { if (wr == 1) GE_BAR; }
    }
    GE_WAIT_V(0);
    GE_BAR;
#undef GE_SA
#undef GE_SB
#undef GE_VA
#undef GE_VB
#undef GE_KSB
#undef GE_HSA
#undef GE_HSB
#undef GE_STAGE
#undef GE_STAGE_A
#undef GE_STAGE_B
#undef GE_LDA
#undef GE_LDB
#undef GE_MMA
#undef GE_WAIT_V
#undef GE_WAIT_L
#undef GE_BAR
#undef GE_SCHED
}

struct StdSched {
    const char* A; const char* B; size_t atile, btile; int nM, nN, nt, nwg, G, c;
    __device__ void init(const void* A_, int lda, const void* B_, int ldb, int M, int N, int K, int G_, int c_) {
        A = (const char*)A_; B = (const char*)B_; atile = (size_t)BM * lda; btile = (size_t)BM * ldb; nM = M / BM; nN = N / BM; nt = K / BK; nwg = nM * nN; G = G_; c = c_; }
    __device__ __forceinline__ bool seg(int i, Seg& s) const {
        const long L = (long)i * G + c; if (L >= nwg) return false;
        int wgid = (int)L; { const int q = nwg / 8, r = nwg % 8, xcd = wgid % 8, off = wgid / 8; wgid = (xcd < r ? xcd * (q + 1) : r * (q + 1) + (xcd - r) * q) + off; }
        const int nig = 4 * nN, gid = wgid / nig, fm = gid * 4, gsz = (nM - fm) < 4 ? (nM - fm) : 4;
        const int pm = fm + ((wgid % nig) % gsz), pn = (wgid % nig) / gsz;
        s.A = A + (size_t)pm * atile; s.B = B + (size_t)pn * btile; s.nt = nt; s.flags = 1; s.geo = 0; s.pm = pm; s.pn = pn; s.aux = i; s.bjmask = 3; return true;
    }
};
}

struct Args { const float* in[31]; float* out; unsigned char* ws; int ph_lo, ph_hi; };
struct Frame {
    LAS unsigned char* lds;
    int tid, lane, wave, G, bid;
    const Args* a;
    float* out;
    unsigned char* ws;
};
#define FIN(k) (F.a->in[k])
__device__ __forceinline__ float wave_sum(float v) {
#pragma unroll
    for (int o = 1; o < 64; o <<= 1) v += __shfl_xor(v, o);
    return v;
}
__device__ __forceinline__ float wave_max(float v) {
#pragma unroll
    for (int o = 1; o < 64; o <<= 1) v = fmaxf(v, __shfl_xor(v, o));
    return v;
}

constexpr int KVR0 = 32 * 127, KVR1 = KVR0 + 32 * 511, KVNR = KVR1 + 32 * 2047;
constexpr int BGW_P0 = 9, BGW_T = 24, BGW_XS = 4, BGW_XA = 5;
constexpr int BGW_S2 = 6, BGW_S7 = 4, BGW_S8 = 5, BGW_S9 = 4, BGW_S11 = 6, BG_NF = 224;
constexpr int BGO_P0 = 0, BGO_P1 = BGO_P0 + 256 * BGW_P0, BGO_P3 = BGO_P1 + 128 * BGW_T, BGO_XS = BGO_P3 + 192 * BGW_T, BGO_XA = BGO_XS + 128 * BGW_XS,
              BGO_P10 = BGO_XA + 128 * BGW_XA, BGO_S2 = BGO_P10 + 128 * BGW_T, BGO_S7 = BGO_S2 + BG_NF * BGW_S2, BGO_S8 = BGO_S7 + BG_NF * BGW_S7,
              BGO_S9 = BGO_S8 + BG_NF * BGW_S8, BGO_S11 = BGO_S9 + BG_NF * BGW_S9, BGW_TOT = BGO_S11 + BG_NF * BGW_S11;
__device__ __forceinline__ void kv_row_ptrs(Frame& F, int rho, const GAS f32x4*& src, GAS f32x4*& dst) {
    const int g = rho < KVR0 ? 0 : (rho < KVR1 ? 1 : 2);
    const int e = rho - (g == 0 ? 0 : (g == 1 ? KVR0 : KVR1)), Wm1 = (128 << (2 * g)) - 1, sb = e / Wm1, rr = e - sb * Wm1;
    const size_t ro = ((size_t)sb * (Wm1 + 1) + rr) * 128;
    src = (const GAS f32x4*)FIN(4 + g) + ro + 128; dst = (GAS f32x4*)(F.out + (g == 0 ? O_SKV0 : g == 1 ? O_SKV1 : O_SKV2)) + ro;
}
__device__ __forceinline__ void bg_copy(Frame& F, int wlo, int whi, int rank, int nw) {
    const int r_lo = (int)((long)KVNR * wlo / BGW_TOT), r_hi = (int)((long)KVNR * whi / BGW_TOT);
    for (int r0 = r_lo + 8 * rank; r0 < r_hi; r0 += 8 * nw) {
        f32x4 t[16]; GAS f32x4* dp[8];
#pragma unroll
        for (int k = 0; k < 8; ++k) { const int rho = (r0 + k < r_hi) ? r0 + k : r_lo; const GAS f32x4* sp; kv_row_ptrs(F, rho, sp, dp[k]); if (r0 + k >= r_hi) dp[k] = nullptr;
            t[2 * k] = __builtin_nontemporal_load(sp + F.lane); t[2 * k + 1] = __builtin_nontemporal_load(sp + 64 + F.lane); }
#pragma unroll
        for (int k = 0; k < 8; ++k) if (dp[k]) { __builtin_nontemporal_store(t[2 * k], dp[k] + F.lane); __builtin_nontemporal_store(t[2 * k + 1], dp[k] + 64 + F.lane); }
    }
}


__device__ __forceinline__ void p0_transpose_item(const float* W, int K, int N, bf16* WT, int drow0, LAS float* scr, int k0, int n0, const float* scale, int lane) {
    float wv[32];
#pragma unroll
    for (int i = 0; i < 32; ++i) { const int kk = 2 * i + (lane >> 5); wv[i] = __builtin_nontemporal_load(W + (size_t)(k0 + kk) * N + n0 + (lane & 31)); }
    if (scale) {
#pragma unroll
        for (int i = 0; i < 32; ++i) wv[i] *= scale[k0 + 2 * i + (lane >> 5)];
    }
#pragma unroll
    for (int i = 0; i < 32; ++i) scr[(2 * i + (lane >> 5)) * 33 + (lane & 31)] = wv[i];
    LDS_WAIT(); asm volatile("" ::: "memory");
    const int c = lane & 7;
#pragma unroll
    for (int j = 0; j < 4; ++j) { const int n = (lane >> 3) + 8 * j; const LAS float* s = scr + (8 * c) * 33 + n;
        u32x4 o; o.x = pk2(s[0 * 33], s[1 * 33]); o.y = pk2(s[2 * 33], s[3 * 33]); o.z = pk2(s[4 * 33], s[5 * 33]); o.w = pk2(s[6 * 33], s[7 * 33]);
        *(GAS u32x4*)(WT + (size_t)(drow0 + n) * K + k0 + 8 * c) = o; }
    LDS_WAIT(); asm volatile("" ::: "memory");
}
__device__ __forceinline__ int rmap_ident(int n0) { return n0; }
__device__ __forceinline__ int rmap_gate(int n0) { return 256 * (n0 >> 7) + (n0 & 127); }
__device__ __forceinline__ int rmap_up(int n0) { return 256 * (n0 >> 7) + 128 + (n0 & 127); }
__device__ __forceinline__ int rmap_win(int n0) { const int cl = n0 & 255; return (n0 & ~255) + 128 * ((cl & 63) >> 5) + 32 * (cl >> 6); }

__device__ __forceinline__ void sincos_rev(float r, float& s, float& c) {
    const float q = rintf(4.0f * r); const float f = r - 0.25f * q;
    const float x = f * 6.283185307179586f, z = x * x;
    const float sp = x + x * z * (-1.6666654611e-1f + z * (8.3321608736e-3f + z * (-1.9515295891e-4f)));
    const float cp = 1.0f - 0.5f * z + z * z * (4.166664568298827e-2f + z * (-1.388731625493765e-3f + z * 2.443315711809948e-5f));
    const int qi = ((int)q) & 3;
    s = (qi == 0) ? sp : (qi == 1) ? cp : (qi == 2) ? -sp : -cp;
    c = (qi == 0) ? cp : (qi == 1) ? -sp : (qi == 2) ? -cp : sp;
}
struct SsmP { float a, rb, fr, fi; };
__device__ __forceinline__ SsmP ssm_param(const Frame& F, int g, int p) {
    const float lr = fminf(FIN(13)[g * 64 + p], -1e-4f), li = FIN(14)[g * 64 + p];
    const float dt = __expf(FIN(20)[g]);
    SsmP o; o.a = lr * dt; const float b = li * dt; o.rb = b * 0.15915494309189535f;
    float s, c; sincos_rev(o.rb, s, c);
    const float a = o.a;
    const float em1 = (fabsf(a) < 0.1f) ? a * (1.0f + a * (0.5f + a * (0.16666667f + a * (0.041666668f + a * (0.0083333338f + a * 0.0013888889f))))) : (__expf(a) - 1.0f);
    float sh, chh; sincos_rev(0.5f * o.rb, sh, chh);
    const float cm1 = -2.0f * sh * sh;
    const float nr = em1 * c + cm1, ni = (em1 + 1.0f) * s;
    const float den = lr * lr + li * li;
    o.fr = (nr * lr + ni * li) / den; o.fi = (ni * lr - nr * li) / den;
    return o;
}
__device__ __forceinline__ void ssm_pow(const SsmP& P, int k, float& re, float& im) {
    const float mag = __expf(P.a * (float)k); float s, c; sincos_rev(P.rb * (float)k, s, c); re = mag * c; im = mag * s;
}
__device__ __forceinline__ void p0_ssm_task(const Frame& F, int g, int j, LAS float* scr) {
    const int lane = F.lane, p = lane;
    const SsmP P = ssm_param(F, g, p);
    const float* bre = FIN(15) + (size_t)(g * 64 + p) * 16; const float* bim = FIN(16) + (size_t)(g * 64 + p) * 16;
    float bbr[16], bbi[16];
#pragma unroll
    for (int c = 0; c < 16; ++c) { const float br = bre[c], bi = bim[c]; bbr[c] = P.fr * br - P.fi * bi; bbi[c] = P.fr * bi + P.fi * br; }
    bf16* KT = (bf16*)(F.ws + WS_KT) + (size_t)g * (KT_STRIDE / 2);
    bf16* BH = (bf16*)(F.ws + WS_BH) + (size_t)g * 512 * 128;
    bf16* W1T = (bf16*)(F.ws + WS_W1T) + (size_t)g * 128 * 512;
    { float ar, ai; ssm_pow(P, j, ar, ai);
#pragma unroll
      for (int c = 0; c < 16; ++c) { scr[p * 16 + c] = ar * bbr[c] - ai * bbi[c]; scr[1024 + p * 16 + c] = ar * bbi[c] + ai * bbr[c]; }
      LDS_WAIT(); asm volatile("" ::: "memory");
      const int co = lane >> 2, ci = 4 * (lane & 3);
      const float* cre = FIN(17) + (size_t)(g * 16 + co) * 64; const float* cim = FIN(18) + (size_t)(g * 16 + co) * 64;
      f32x4 acc = (f32x4){0.f, 0.f, 0.f, 0.f};
      for (int pp = 0; pp < 64; ++pp) { const float cr = cre[pp], cii = cim[pp];
          const f32x4 er = *(const LAS f32x4*)(scr + pp * 16 + ci), ei = *(const LAS f32x4*)(scr + 1024 + pp * 16 + ci);
          acc += cr * er - cii * ei; }
      if (j == 0) { const float dv = FIN(19)[g * 16 + co];
#pragma unroll
          for (int k = 0; k < 4; ++k) if (ci + k == co) acc[k] += dv; }
      u32x2 o; o.x = pk2(acc[0], acc[1]); o.y = pk2(acc[2], acc[3]);
      *(GAS u32x2*)(KT + (size_t)(j + 15) * 256 + co * 16 + ci) = o;
      LDS_WAIT(); asm volatile("" ::: "memory");
    }
    { float ar, ai; ssm_pow(P, j + 1, ar, ai);
#pragma unroll 4
      for (int co = 0; co < 16; ++co) { const float cr = FIN(17)[(size_t)(g * 16 + co) * 64 + p], cii = FIN(18)[(size_t)(g * 16 + co) * 64 + p];
          bf16* row = BH + (size_t)(j * 16 + co) * 128;
          row[p] = (bf16)f2bf(cr * ar - cii * ai); row[64 + p] = (bf16)f2bf(-(cr * ai + cii * ar)); }
    }
    { float ar, ai; ssm_pow(P, 31 - j, ar, ai);
      u32x4 r0, r1, i0, i1; float er[16], ei[16];
#pragma unroll
      for (int c = 0; c < 16; ++c) { er[c] = ar * bbr[c] - ai * bbi[c]; ei[c] = ar * bbi[c] + ai * bbr[c]; }
      r0.x = pk2(er[0], er[1]); r0.y = pk2(er[2], er[3]); r0.z = pk2(er[4], er[5]); r0.w = pk2(er[6], er[7]);
      r1.x = pk2(er[8], er[9]); r1.y = pk2(er[10], er[11]); r1.z = pk2(er[12], er[13]); r1.w = pk2(er[14], er[15]);
      i0.x = pk2(ei[0], ei[1]); i0.y = pk2(ei[2], ei[3]); i0.z = pk2(ei[4], ei[5]); i0.w = pk2(ei[6], ei[7]);
      i1.x = pk2(ei[8], ei[9]); i1.y = pk2(ei[10], ei[11]); i1.z = pk2(ei[12], ei[13]); i1.w = pk2(ei[14], ei[15]);
      GAS u32x4* wr_ = (GAS u32x4*)(W1T + (size_t)p * 512 + j * 16); wr_[0] = r0; wr_[1] = r1;
      GAS u32x4* wi_ = (GAS u32x4*)(W1T + (size_t)(64 + p) * 512 + j * 16); wi_[0] = i0; wi_[1] = i1;
    }
    if (j == 0) {
        for (int q = lane; q < 480; q += 64) ((GAS u32x4*)KT)[q] = (u32x4){0u, 0u, 0u, 0u};
        float* sp = (float*)(F.ws + WS_SSMP);
        float ar, ai; ssm_pow(P, 32, ar, ai);
        sp[SSMP_A32 / 4 + (g * 64 + p) * 2] = ar; sp[SSMP_A32 / 4 + (g * 64 + p) * 2 + 1] = ai;
        ssm_pow(P, 1, ar, ai);
        sp[SSMP_A1 / 4 + (g * 64 + p) * 2] = ar; sp[SSMP_A1 / 4 + (g * 64 + p) * 2 + 1] = ai;
#pragma unroll
        for (int c = 0; c < 16; ++c) { sp[SSMP_BB / 4 + ((size_t)(g * 64 + p) * 16 + c) * 2] = bbr[c]; sp[SSMP_BB / 4 + ((size_t)(g * 64 + p) * 16 + c) * 2 + 1] = bbi[c]; }
    }
}
__device__ __forceinline__ void p0_prologue(Frame& F) {
    LAS float* scr = (LAS float*)(F.lds + F.wave * 16384);
    const int gw = F.bid * NWAVES + F.wave, NGW = F.G * NWAVES;
    constexpr int I_G = (DM / 64) * (FF / 32), I_D = (FF / 64) * (DM / 32), I_IN = (DM / 64) * (NIN / 32), I_SQ = (DM / 64) * (DM / 32), I_PB = (SW / 64) * (DM / 32);
    constexpr int NITEMS = 4 * I_G + 2 * I_D + I_IN + 3 * I_SQ + I_PB;
    for (int it = gw; it < NITEMS; it += NGW) {
        int r = it;
#define TR_ITEM(cnt, W_, K_, N_, WT_, rmap, scale_) if (r < (cnt)) { const int nblk = (N_) / 32, kb = r / nblk, nb = r % nblk; \
            p0_transpose_item(W_, K_, N_, (bf16*)(F.ws + (WT_)), rmap(32 * nb), scr, 64 * kb, 32 * nb, scale_, F.lane); continue; } r -= (cnt);
        TR_ITEM(I_G, FIN(8), DM, FF, WS_WGU1, rmap_gate, FIN(7))
        TR_ITEM(I_G, FIN(9), DM, FF, WS_WGU1, rmap_up, FIN(7))
        TR_ITEM(I_D, FIN(10), FF, DM, WS_WD1, rmap_ident, nullptr)
        TR_ITEM(I_IN, FIN(12), DM, NIN, WS_WIN, rmap_win, FIN(11))
        TR_ITEM(I_SQ, FIN(21), DM, DM, WS_WGLU, rmap_ident, nullptr)
        TR_ITEM(I_SQ, FIN(24), DM, DM, WS_WPA, rmap_ident, nullptr)
        TR_ITEM(I_SQ, FIN(26), DM, DM, WS_WOUT, rmap_ident, nullptr)
        TR_ITEM(I_PB, FIN(25), SW, DM, WS_WPB, rmap_ident, nullptr)
        TR_ITEM(I_G, FIN(28), DM, FF, WS_WGU2, rmap_gate, FIN(27))
        TR_ITEM(I_G, FIN(29), DM, FF, WS_WGU2, rmap_up, FIN(27))
        TR_ITEM(I_D, FIN(30), FF, DM, WS_WD2, rmap_ident, nullptr)
#undef TR_ITEM
    }
    {
        bf16* XB = (bf16*)(F.ws + WS_XBF); float* SS0 = (float*)(F.ws + WS_SS0);
        for (int m0 = 2 * gw; m0 < MPR + NSMP; m0 += 2 * NGW) {
            f32x4 v[2][4];
#pragma unroll
            for (int r = 0; r < 2; ++r) { const int m = m0 + r; const float* xrow = (m < MPR) ? FIN(0) + (size_t)m * DM : FIN(1) + (size_t)(m - MPR) * DM;
                const GAS f32x4* xr = (const GAS f32x4*)xrow + F.lane;
#pragma unroll
                for (int j = 0; j < 4; ++j) v[r][j] = __builtin_nontemporal_load(xr + 64 * j); }
#pragma unroll
            for (int r = 0; r < 2; ++r) { const int m = m0 + r; float s = 0.f;
#pragma unroll
                for (int j = 0; j < 4; ++j) s += (v[r][j].x * v[r][j].x + v[r][j].y * v[r][j].y) + (v[r][j].z * v[r][j].z + v[r][j].w * v[r][j].w);
                s = wave_sum(s);
                GAS u32x2* o8 = (GAS u32x2*)(XB + (size_t)m * DM) + F.lane;
#pragma unroll
                for (int j = 0; j < 4; ++j) { u32x2 o; o.x = pk2(v[r][j].x, v[r][j].y); o.y = pk2(v[r][j].z, v[r][j].w); o8[64 * j] = o; }
                if (F.lane == 0) SS0[m] = s; }
        }
    }
    for (int t = gw; t < NG * 32; t += NGW) p0_ssm_task(F, t >> 5, t & 31, scr);
    if (F.G == 256) bg_copy(F, BGO_P0 + F.bid * BGW_P0, BGO_P0 + (F.bid + 1) * BGW_P0, F.wave, NWAVES);
    else bg_copy(F, (int)((long)BGW_TOT * F.bid / F.G), (int)((long)BGW_TOT * (F.bid + 1) / F.G), F.wave, NWAVES);
}


typedef f32x4 AccT[2][2][4][2];
__device__ __forceinline__ float rsq(float x) { return __builtin_amdgcn_rsqf(x); }
__device__ __forceinline__ float row_rstd16(const float* ssp, int row) {
    const GAS f32x4* p = (const GAS f32x4*)(ssp + (size_t)row * 16);
    const f32x4 a = p[0], b = p[1], c = p[2], d = p[3];
    const float s = ((a.x + a.y) + (a.z + a.w)) + ((b.x + b.y) + (b.z + b.w)) + ((c.x + c.y) + (c.z + c.w)) + ((d.x + d.y) + (d.z + d.w));
    return rsq(s * (1.0f / DM) + RMS_EPS);
}
__device__ __forceinline__ u32x4 pack8(const f32x4& a, const f32x4& b) { u32x4 w; w.x = cvt_pk_bf16(a[0], a[1]); w.y = cvt_pk_bf16(a[2], a[3]); w.z = cvt_pk_bf16(b[0], b[1]); w.w = cvt_pk_bf16(b[2], b[3]); return w; }
__device__ __forceinline__ void unpack8(const u32x4 w, f32x4& a, f32x4& b) { a = (f32x4){bflo(w.x), bfhi(w.x), bflo(w.y), bfhi(w.y)}; b = (f32x4){bflo(w.z), bfhi(w.z), bflo(w.w), bfhi(w.w)}; }

constexpr int RSTAB_OFF = 131584, RSTAB_S_OFF = RSTAB_OFF + 8 * 1024;
static_assert(RSTAB_S_OFF + 128 <= LDS_BYTES && RSTAB_OFF >= MISC_OFF + 128, "LDS map");
template <class Sched> __device__ __forceinline__ void fill_rstd(Frame& F, const Sched& S, const float* ss, int npart) {
    LAS float* tab = (LAS float*)(F.lds + RSTAB_OFF); LAS float* tabs = (LAS float*)(F.lds + RSTAB_S_OFF);
    ge::Seg sg;
    for (int i = 0; i < 8 && S.seg(i, sg); ++i) if (F.tid < 256) { const int row = sg.pm * 256 + F.tid;
        tab[i * 256 + F.tid] = (npart == 1) ? rsq(ss[row] * (1.0f / DM) + RMS_EPS) : row_rstd16(ss, row); }
    if (F.tid < NSMP) { const int row = MPR + F.tid; float r;
        if (npart == 1) r = rsq(ss[row] * (1.0f / DM) + RMS_EPS);
        else { const GAS f32x4* pp = (const GAS f32x4*)((const float*)(F.ws + WS_SSPS) + F.tid * 32); float sm = 0.f;
#pragma unroll
            for (int k = 0; k < 8; ++k) { const f32x4 v = pp[k]; sm += (v.x + v.y) + (v.z + v.w); }
            r = rsq(sm * (1.0f / DM) + RMS_EPS); }
        tabs[F.tid] = r; }
    __syncthreads();
}
struct EpiGateUp {
    const LAS float* rs; bf16* HID;
    template <int AI_N = 2, int M_N = 4> __device__ __forceinline__ void run(const AccT& acc, const ge::Seg& u, int wr, int wc, int fr, int fq) const {
        const int row0 = u.pm * 256 + wr * 64 + fr, col0 = u.pn * 128 + wc * 32 + 8 * fq; const LAS float* rp = rs + u.aux * 256 + wr * 64 + fr;
        float rv[AI_N][M_N];
#pragma unroll
        for (int ai = 0; ai < AI_N; ++ai)
#pragma unroll
            for (int m = 0; m < M_N; ++m) rv[ai][m] = rp[ai * 128 + m * 16];
#pragma unroll
        for (int ai = 0; ai < AI_N; ++ai)
#pragma unroll
            for (int m = 0; m < M_N; ++m) { const int row = row0 + ai * 128 + m * 16; const float rstd = rv[ai][m];
                f32x4 h[2];
#pragma unroll
                for (int n = 0; n < 2; ++n)
#pragma unroll
                    for (int i = 0; i < 4; ++i) { const float g = acc[ai][0][m][n][i] * rstd, up = acc[ai][1][m][n][i] * rstd; h[n][i] = g * sigmoidf_(g) * up; }
                *(GAS u32x4*)(HID + (size_t)row * FF + col0) = pack8(h[0], h[1]); }
    }
};
template <bool FINAL> struct EpiResid {
    float alpha; bf16* xb; float* ssp; float* out; float* ssps;
    template <int AI_N = 2, int M_N = 4> __device__ __forceinline__ void run(const AccT& acc, const ge::Seg& u, int wr, int wc, int fr, int fq) const {
        const int row0 = u.pm * 256 + wr * 64 + fr, col0 = u.pn * 256 + wc * 32 + 8 * fq;
#pragma unroll
        for (int ai = 0; ai < AI_N; ++ai) {
            u32x4 bw[M_N][2];
#pragma unroll
            for (int m = 0; m < M_N; ++m)
#pragma unroll
                for (int bj = 0; bj < 2; ++bj) bw[m][bj] = *(const GAS u32x4*)(xb + (size_t)(row0 + ai * 128 + m * 16) * DM + col0 + bj * 128);
#pragma unroll
            for (int m = 0; m < M_N; ++m) { const int row = row0 + ai * 128 + m * 16; float sq = 0.f;
                const size_t doff = (row < MPR) ? O_YP + (size_t)row * DM : O_YS + (size_t)(row - MPR) * DM;
#pragma unroll
                for (int bj = 0; bj < 2; ++bj) if ((u.bjmask >> bj) & 1) { const size_t off = (size_t)row * DM + col0 + bj * 128;
                    f32x4 b0, b1; unpack8(bw[m][bj], b0, b1);
                    const f32x4 o0 = b0 + alpha * acc[ai][bj][m][0], o1 = b1 + alpha * acc[ai][bj][m][1];
                    if (FINAL) { *(GAS f32x4*)(out + doff + col0 + bj * 128) = o0; *(GAS f32x4*)(out + doff + col0 + bj * 128 + 4) = o1; }
                    else { *(GAS u32x4*)(xb + off) = pack8(o0, o1);
                        sq += (o0[0] * o0[0] + o0[1] * o0[1]) + (o0[2] * o0[2] + o0[3] * o0[3]) + (o1[0] * o1[0] + o1[1] * o1[1]) + (o1[2] * o1[2] + o1[3] * o1[3]); } }
                if (!FINAL) { sq += __shfl_xor(sq, 16); sq += __shfl_xor(sq, 32);
                    if (fq == 0) { if (u.bjmask == 3) ssp[(size_t)row * 16 + u.pn * 4 + wc] = sq; else ssps[(size_t)(row - MPR) * 32 + u.pn * 8 + wc * 2 + (u.bjmask >> 1)] = sq; } } }
        }
    }
};
struct EpiWin {
    const LAS float* rs; bf16 *U, *Q, *K, *V, *GA, *GB; float* US; const float *qg, *kg; float* out;
    __device__ __forceinline__ float* kvdst(int grp, int row, int which) const {
        const int W = 128 << (2 * grp);
        if (row < MPR) { const int b = row >> 12, t = row & 4095; if (t < SEQ - W) return nullptr;
            return out + (grp == 0 ? O_PKV0 : grp == 1 ? O_PKV1 : O_PKV2) + ((size_t)(b * W + t - (SEQ - W)) * 2 + which) * 256; }
        const int sb = row - MPR; return out + (grp == 0 ? O_SKV0 : grp == 1 ? O_SKV1 : O_SKV2) + ((size_t)(sb * W + W - 1) * 2 + which) * 256;
    }
    template <int AI_N = 2, int M_N = 4> __device__ __forceinline__ void run(const AccT& acc, const ge::Seg& u, int wr, int wc, int fr, int fq) const {
        const int row0 = u.pm * 256 + wr * 64 + fr, pn = u.pn, cl0 = 64 * wc + 8 * fq; const LAS float* rp = rs + u.aux * 256 + wr * 64 + fr;
        float rv[AI_N][M_N];
#pragma unroll
        for (int ai = 0; ai < AI_N; ++ai)
#pragma unroll
            for (int m = 0; m < M_N; ++m) rv[ai][m] = rp[ai * 128 + m * 16];
        f32x4 gn[2][2];
        if (pn >= 4 && pn < 10) { const float* gp = (pn < 7) ? qg : kg; const float sc = (pn < 7) ? 0.125f : 1.0f;
#pragma unroll
            for (int bj = 0; bj < 2; ++bj) { gn[bj][0] = *(const GAS f32x4*)(gp + 32 * bj + 8 * fq) * sc; gn[bj][1] = *(const GAS f32x4*)(gp + 32 * bj + 8 * fq + 4) * sc; } }
#pragma unroll
        for (int ai = 0; ai < AI_N; ++ai)
#pragma unroll
            for (int m = 0; m < M_N; ++m) { const int row = row0 + ai * 128 + m * 16;
                const float rstd = rv[ai][m];
                f32x4 v[2][2];
#pragma unroll
                for (int bj = 0; bj < 2; ++bj)
#pragma unroll
                    for (int n = 0; n < 2; ++n) v[bj][n] = acc[ai][bj][m][n] * rstd;
                if (pn < 4) {
#pragma unroll
                    for (int bj = 0; bj < 2; ++bj) { const int c = 256 * pn + cl0 + 32 * bj, g = c >> 4, c0 = c & 15;
                        if (row < MPR) { const int b = row >> 12, t = row & 4095; *(GAS u32x4*)(U + ((size_t)((g * 4 + b) * SEQ + t)) * 16 + c0) = pack8(v[bj][0], v[bj][1]); }
                        else { float* d = US + (size_t)(row - MPR) * DM + c; *(GAS f32x4*)d = v[bj][0]; *(GAS f32x4*)(d + 4) = v[bj][1]; } }
                } else if (pn < 10) {
                    const bool isq = pn < 7; const int grp = isq ? pn - 4 : pn - 7;
                    float sq = 0.f;
#pragma unroll
                    for (int bj = 0; bj < 2; ++bj)
#pragma unroll
                        for (int n = 0; n < 2; ++n) sq += (v[bj][n][0] * v[bj][n][0] + v[bj][n][1] * v[bj][n][1]) + (v[bj][n][2] * v[bj][n][2] + v[bj][n][3] * v[bj][n][3]);
                    sq += __shfl_xor(sq, 16); sq += __shfl_xor(sq, 32);
                    const float r = rsq(sq * (1.0f / HD) + RMS_EPS);
                    float* kd = isq ? nullptr : kvdst(grp, row, 0);
#pragma unroll
                    for (int bj = 0; bj < 2; ++bj) { const int d0 = 32 * bj + 8 * fq;
                        const f32x4 o0 = v[bj][0] * r * gn[bj][0], o1 = v[bj][1] * r * gn[bj][1];
                        *(GAS u32x4*)((isq ? Q : K) + (size_t)row * AW + grp * 256 + wc * 64 + d0) = pack8(o0, o1);
                        if (kd) { *(GAS f32x4*)(kd + wc * 64 + d0) = o0; *(GAS f32x4*)(kd + wc * 64 + d0 + 4) = o1; } }
                } else if (pn < 13) {
                    const int grp = pn - 10; float* vd = kvdst(grp, row, 1);
#pragma unroll
                    for (int bj = 0; bj < 2; ++bj) { const int d0 = 32 * bj + 8 * fq;
                        *(GAS u32x4*)(V + (size_t)row * AW + grp * 256 + wc * 64 + d0) = pack8(v[bj][0], v[bj][1]);
                        if (vd) { *(GAS f32x4*)(vd + wc * 64 + d0) = v[bj][0]; *(GAS f32x4*)(vd + wc * 64 + d0 + 4) = v[bj][1]; } }
                } else {
                    bf16* G = pn < 17 ? GA : GB; const int cb = 256 * (pn < 17 ? pn - 13 : pn - 17);
#pragma unroll
                    for (int bj = 0; bj < 2; ++bj) { f32x4 s0, s1;
#pragma unroll
                        for (int i = 0; i < 4; ++i) { s0[i] = sigmoidf_(v[bj][0][i]); s1[i] = sigmoidf_(v[bj][1][i]); }
                        *(GAS u32x4*)(G + (size_t)row * DM + cb + cl0 + 32 * bj) = pack8(s0, s1); }
                } }
    }
};
struct EpiState {
    float* SST;
    template <int AI_N = 2, int M_N = 4> __device__ __forceinline__ void run(const AccT& acc, const ge::Seg& u, int wr, int wc, int fr, int fq) const {
        const int r0 = u.pm * 256 + wr * 64 + fr;
#pragma unroll
        for (int ai = 0; ai < AI_N; ++ai)
#pragma unroll
            for (int m = 0; m < M_N; ++m) { float* d = SST + ((size_t)u.aux * 512 + r0 + ai * 128 + m * 16) * 128 + wc * 32 + 8 * fq;
                *(GAS f32x4*)d = acc[ai][0][m][0]; *(GAS f32x4*)(d + 4) = acc[ai][0][m][1]; }
    }
};
struct EpiSsmY {
    bf16* YS;
    template <int AI_N = 2, int M_N = 4> __device__ __forceinline__ void run(const AccT& acc, const ge::Seg& u, int wr, int wc, int fr, int fq) const {
        const int g = u.aux, r0 = u.pm * 256 + wr * 64 + fr;
#pragma unroll
        for (int ai = 0; ai < AI_N; ++ai)
#pragma unroll
            for (int m = 0; m < M_N; ++m) { const int r = r0 + ai * 128 + m * 16, b = r >> 7, chunk = r & 127;
#pragma unroll
                for (int bj = 0; bj < 2; ++bj) { const int slot = 128 * bj + 32 * wc + 8 * fq, tp = 16 * u.pn + (slot >> 4), co0 = slot & 15;
                    f32x4 y0 = acc[ai][bj][m][0], y1 = acc[ai][bj][m][1];
#pragma unroll
                    for (int i = 0; i < 4; ++i) { y0[i] = gelu_tanh(y0[i]); y1[i] = gelu_tanh(y1[i]); }
                    const size_t tok = (size_t)b * SEQ + chunk * CH + tp;
                    *(GAS u32x4*)(YS + tok * DM + g * 16 + co0) = pack8(y0, y1); } }
    }
};
template <int MODE> struct EpiElem {
    const bf16* P; const bf16* Q2; bf16* O;
    template <int AI_N = 2, int M_N = 4> __device__ __forceinline__ void run(const AccT& acc, const ge::Seg& u, int wr, int wc, int fr, int fq) const {
        const int row0 = u.pm * 256 + wr * 64 + fr, col0 = u.pn * 256 + wc * 32 + 8 * fq;
#pragma unroll
        for (int ai = 0; ai < AI_N; ++ai) {
            u32x4 pw[M_N][2], qw[M_N][2];
#pragma unroll
            for (int m = 0; m < M_N; ++m)
#pragma unroll
                for (int bj = 0; bj < 2; ++bj) if ((u.bjmask >> bj) & 1) { const size_t off = (size_t)(row0 + ai * 128 + m * 16) * DM + col0 + bj * 128;
                    pw[m][bj] = *(const GAS u32x4*)(P + off); if (MODE == 2) qw[m][bj] = *(const GAS u32x4*)(Q2 + off); }
#pragma unroll
            for (int m = 0; m < M_N; ++m)
#pragma unroll
                for (int bj = 0; bj < 2; ++bj) if ((u.bjmask >> bj) & 1) { const size_t off = (size_t)(row0 + ai * 128 + m * 16) * DM + col0 + bj * 128;
                    f32x4 p0, p1; unpack8(pw[m][bj], p0, p1);
                    f32x4 o0, o1; const f32x4 a0 = acc[ai][bj][m][0], a1 = acc[ai][bj][m][1];
                    if (MODE == 0) {
#pragma unroll
                        for (int i = 0; i < 4; ++i) { o0[i] = p0[i] * sigmoidf_(a0[i]); o1[i] = p1[i] * sigmoidf_(a1[i]); }
                    } else if (MODE == 1) { o0 = p0 * a0; o1 = p1 * a1; }
                    else { f32x4 q0, q1; unpack8(qw[m][bj], q0, q1); o0 = p0 * a0 + q0; o1 = p1 * a1 + q1; }
                    *(GAS u32x4*)(O + off) = pack8(o0, o1); }
        }
    }
};

template <class Epi>
__device__ __forceinline__ void skinny_unit(LAS unsigned char* lds, const bf16* A, int lda, const bf16* Bt, int ldb, int K, const Epi& E, int pn, int wc, int bjmask) {
    const int tid = threadIdx.x, w = __builtin_amdgcn_readfirstlane(tid >> 6), lane = tid & 63, fr = lane & 15, fq = lane >> 4;
    const int kw = K / 8, k00 = w * kw;
    f32x4 acc[2][2][2];
#pragma unroll
    for (int b = 0; b < 2; ++b)
#pragma unroll
        for (int m = 0; m < 2; ++m)
#pragma unroll
            for (int n = 0; n < 2; ++n) acc[b][m][n] = (f32x4){0.f, 0.f, 0.f, 0.f};
    const bf16* Ar = A + (size_t)(MPR + fr) * lda + k00 + 8 * fq;
    const bf16* Br = Bt + (size_t)(pn * 256 + 32 * wc + 8 * (fr >> 2) + (fr & 3)) * ldb + k00 + 8 * fq;
#pragma unroll 4
    for (int ks = 0; ks < kw; ks += 32) {
        bf16x8 a[2];
#pragma unroll
        for (int m = 0; m < 2; ++m) a[m] = *(const GAS bf16x8*)(Ar + (size_t)(16 * m) * lda + ks);
#pragma unroll
        for (int b = 0; b < 2; ++b) if ((bjmask >> b) & 1) {
#pragma unroll
            for (int n = 0; n < 2; ++n) { const bf16x8 bf = *(const GAS bf16x8*)(Br + (size_t)(128 * b + 4 * n) * ldb + ks);
#pragma unroll
                for (int m = 0; m < 2; ++m) acc[b][m][n] = __builtin_amdgcn_mfma_f32_16x16x32_bf16(bf, a[m], acc[b][m][n], 0, 0, 0); } }
    }
    LAS f32x4* T = (LAS f32x4*)lds;
#define SK_WR(slot) do { _Pragma("unroll") for (int b = 0; b < 2; ++b) _Pragma("unroll") for (int m = 0; m < 2; ++m) _Pragma("unroll") for (int n = 0; n < 2; ++n) T[(slot) * 512 + (((b * 2 + m) * 2 + n) * 64) + lane] = acc[b][m][n]; } while (0)
#define SK_ADD(slot) do { _Pragma("unroll") for (int b = 0; b < 2; ++b) _Pragma("unroll") for (int m = 0; m < 2; ++m) _Pragma("unroll") for (int n = 0; n < 2; ++n) acc[b][m][n] = acc[b][m][n] + T[(slot) * 512 + (((b * 2 + m) * 2 + n) * 64) + lane]; } while (0)
    if (w >= 4) SK_WR(w - 4);
    __syncthreads();
    if (w < 4) SK_ADD(w);
    if (w == 2 || w == 3) SK_WR(4 + (w - 2));
    __syncthreads();
    if (w < 2) SK_ADD(4 + w);
    if (w == 1) SK_WR(6);
    __syncthreads();
    if (w == 0) {
        SK_ADD(6);
        AccT o;
#pragma unroll
        for (int b = 0; b < 2; ++b)
#pragma unroll
            for (int m = 0; m < 2; ++m)
#pragma unroll
                for (int n = 0; n < 2; ++n) o[0][b][m][n] = acc[b][m][n];
        ge::Seg u; u.A = nullptr; u.B = nullptr; u.nt = 0; u.flags = 1; u.geo = 0; u.pm = MPR / 256; u.pn = pn; u.aux = 0; u.bjmask = bjmask;
        E.template run<1, 2>(o, u, 0, wc, fr, fq);
    }
#undef SK_WR
#undef SK_ADD
    __syncthreads();
}
template <bool SPLIT, class Epi>
__device__ __forceinline__ void skinny_phase(Frame& F, const void* A, int lda, const void* Bt, int ldb, int N, int K, const Epi& E) {
    const int nS = SPLIT ? N / 32 : N / 64;
    for (int j = F.G - 1 - F.bid; j < nS; j += F.G) {
        if (SPLIT) skinny_unit(F.lds, (const bf16*)A, lda, (const bf16*)Bt, ldb, K, E, j >> 3, (j >> 1) & 3, 1 << (j & 1));
        else skinny_unit(F.lds, (const bf16*)A, lda, (const bf16*)Bt, ldb, K, E, j >> 2, j & 3, 3); }
}

struct StateSched {
    const char* U; const char* W1T; int G, c;
    __device__ __forceinline__ bool seg(int i, ge::Seg& s) const {
        const int un = i * G + c; if (un >= 128) return false;
        const int g = un >> 1, pm = un & 1;
        s.A = U + ((size_t)g * 512 + 256 * pm) * 1024; s.B = W1T + (size_t)g * 128 * 1024; s.nt = 8; s.flags = 1; s.geo = 0; s.pm = pm; s.pn = 0; s.aux = g; s.bjmask = 3; return true;
    }
};
struct SsmYSched {
    const char* HS; const char* BH; const char* U; const char* KT; int G, c;
    __device__ __forceinline__ bool seg(int i, ge::Seg& s) const {
        const int un = (i >> 1) * G + c; if (un >= 256) return false;
        const int g = un >> 2, pm = (un >> 1) & 1, pn = un & 1;
        s.pm = pm; s.pn = pn; s.aux = g; s.bjmask = 3;
        if ((i & 1) == 0) { s.A = HS + ((size_t)g * 512 + 256 * pm) * 256; s.B = BH + ((size_t)g * 512 + 256 * pn) * 256; s.nt = 2; s.flags = 0; s.geo = 0; }
        else { s.A = U + ((size_t)g * 512 + 256 * pm) * 1024; s.B = KT + (size_t)g * KT_STRIDE + (size_t)(16 * pn) * 512; s.nt = 4 * (pn + 1); s.flags = 1; s.geo = 1; }
        return true;
    }
};

struct SsmYSchedB {
    const char* HS; const char* BH; const char* U; const char* KT; int c;
    __device__ __forceinline__ bool seg(int i, ge::Seg& s) const {
        if (i >= 4) return false;
        const int g = c >> 1, pm = c & 1, pn = i >> 1;
        s.pm = pm; s.pn = pn; s.aux = g; s.bjmask = 3;
        if ((i & 1) == 0) { s.A = HS + ((size_t)g * 512 + 256 * pm) * 256; s.B = BH + ((size_t)g * 512 + 256 * pn) * 256; s.nt = 2; s.flags = 0; s.geo = 0; }
        else { s.A = U + ((size_t)g * 512 + 256 * pm) * 1024; s.B = KT + (size_t)g * KT_STRIDE + (size_t)(16 * pn) * 512; s.nt = 4 * (pn + 1); s.flags = 1; s.geo = 1; }
        return true;
    }
};

constexpr int ATT_RB = 144;
constexpr int ATT_K = 0, ATT_V = 384 * ATT_RB;
constexpr float LOG2E = 1.4426950408889634f, LN2 = 0.6931471805599453f;
__device__ __forceinline__ float alibi_slope(int g, int hc) { return exp2f(-8.0f * (float)(4 * g + hc + 1) / 12.0f); }
__device__ __forceinline__ void attn_item(Frame& F, int it) {
    const int g = it >> 8, rem = it & 255, b = rem >> 6, hc = (rem >> 4) & 3, idx = rem & 15;
    const int dsh = 2 * g, d = 1 << dsh, r = idx & (d - 1), qb = idx >> dsh, i0 = qb * 256;
    const bf16* Qg = (const bf16*)(F.ws + WS_Q) + g * 256 + hc * 64;
    const bf16* Kg = (const bf16*)(F.ws + WS_K) + g * 256 + hc * 64;
    const bf16* Vg = (const bf16*)(F.ws + WS_V) + g * 256 + hc * 64;
    LAS unsigned char* lds = F.lds;
    {
        const int piece = F.tid & 7;
#pragma unroll
        for (int pass = 0; pass < 6; ++pass) { const int rho = pass * 64 + (F.tid >> 3), i = i0 - 128 + rho;
            u32x4 kv = (u32x4){0u, 0u, 0u, 0u}, vv = kv;
            if (i >= 0) { const size_t tok = (size_t)b * SEQ + (size_t)i * d + r; kv = *(const GAS u32x4*)(Kg + tok * AW + piece * 8); vv = *(const GAS u32x4*)(Vg + tok * AW + piece * 8); }
            *(LAS u32x4*)(lds + ATT_K + rho * ATT_RB + piece * 16) = kv; *(LAS u32x4*)(lds + ATT_V + rho * ATT_RB + piece * 16) = vv; }
    }
    __syncthreads();
    const int w = F.wave, lane = F.lane, ql = lane & 31, h = lane >> 5;
    const size_t tokq = (size_t)b * SEQ + (size_t)(i0 + 32 * w + ql) * d + r;
    bf16x8 qf[4];
#pragma unroll
    for (int s = 0; s < 4; ++s) qf[s] = *(const GAS bf16x8*)(Qg + tokq * AW + 16 * s + 8 * h);
    f32x16 st[5];
#pragma unroll
    for (int j = 0; j < 5; ++j) { st[j] = (f32x16){0.f, 0.f, 0.f, 0.f, 0.f, 0.f, 0.f, 0.f, 0.f, 0.f, 0.f, 0.f, 0.f, 0.f, 0.f, 0.f};
#pragma unroll
        for (int s = 0; s < 4; ++s) { const bf16x8 kf = *(const LAS bf16x8*)(lds + ATT_K + (32 * w + 32 * j + ql) * ATT_RB + (16 * s + 8 * h) * 2);
            st[j] = __builtin_amdgcn_mfma_f32_32x32x16_bf16(kf, qf[s], st[j], 0, 0, 0); } }
    const float sl2 = alibi_slope(g, hc) * (float)d * LOG2E;
    float mx = -3.0e38f;
#pragma unroll
    for (int j = 0; j < 5; ++j)
#pragma unroll
        for (int rg = 0; rg < 16; ++rg) { const int kvl = (rg & 3) + 8 * (rg >> 2) + 4 * h, delta = 128 + ql - 32 * j - kvl, ikv = i0 - 128 + 32 * w + 32 * j + kvl;
            const bool ok = (delta >= 0) && (delta <= 128) && (ikv >= 0);
            const float s2 = ok ? (st[j][rg] * LOG2E - sl2 * (float)delta) : -3.0e38f;
            st[j][rg] = s2; mx = fmaxf(mx, s2); }
    mx = fmaxf(mx, __shfl_xor(mx, 32));
    float den = 0.f;
#pragma unroll
    for (int j = 0; j < 5; ++j)
#pragma unroll
        for (int rg = 0; rg < 16; ++rg) { const float p = fast_exp2(st[j][rg] - mx); st[j][rg] = p; den += p; }
    den += __shfl_xor(den, 32);
    const float inv = 1.0f / den;
    if (h == 0) ((float*)(F.ws + WS_LSE))[((size_t)g * MPR + tokq) * 4 + hc] = (mx + __log2f(den)) * LN2;
    const int qq = (lane & 15) >> 2, pp = lane & 3, gsel = (lane >> 4) & 1;
    f32x16 o[2];
#pragma unroll
    for (int db = 0; db < 2; ++db) { o[db] = (f32x16){0.f, 0.f, 0.f, 0.f, 0.f, 0.f, 0.f, 0.f, 0.f, 0.f, 0.f, 0.f, 0.f, 0.f, 0.f, 0.f}; }
#pragma unroll
    for (int j = 0; j < 5; ++j)
#pragma unroll
        for (int sp = 0; sp < 2; ++sp) {
            u32x4 pw; pw.x = cvt_pk_bf16(st[j][8 * sp + 0] * inv, st[j][8 * sp + 1] * inv); pw.y = cvt_pk_bf16(st[j][8 * sp + 2] * inv, st[j][8 * sp + 3] * inv);
            pw.z = cvt_pk_bf16(st[j][8 * sp + 4] * inv, st[j][8 * sp + 5] * inv); pw.w = cvt_pk_bf16(st[j][8 * sp + 6] * inv, st[j][8 * sp + 7] * inv);
            const bf16x8 pa = __builtin_bit_cast(bf16x8, pw);
#pragma unroll
            for (int db = 0; db < 2; ++db) {
                LAS unsigned char* vp = lds + ATT_V + (32 * w + 32 * j + 16 * sp + 4 * h + qq) * ATT_RB + (32 * db + 16 * gsel + 4 * pp) * 2;
                const s16x4 lo = __builtin_bit_cast(s16x4, __builtin_amdgcn_ds_read_tr16_b64_v4i16((LAS s16x4*)vp));
                const s16x4 hi = __builtin_bit_cast(s16x4, __builtin_amdgcn_ds_read_tr16_b64_v4i16((LAS s16x4*)(vp + 8 * ATT_RB)));
                const bf16x8 vb = (bf16x8){lo[0], lo[1], lo[2], lo[3], hi[0], hi[1], hi[2], hi[3]};
                o[db] = __builtin_amdgcn_mfma_f32_32x32x16_bf16(pa, vb, o[db], 0, 0, 0); } }
    const int odd = lane & 1;
    bf16* OG = (bf16*)(F.ws + WS_OG) + (size_t)g * MPR * SW + hc * 64 + ((lane & 31) - odd) + 32 * odd;
#pragma unroll
    for (int rg = 0; rg < 16; ++rg) { const int qrow = (rg & 3) + 8 * (rg >> 2) + 4 * h; const size_t tok = (size_t)b * SEQ + (size_t)(i0 + 32 * w + qrow) * d + r;
        const float p0 = __shfl_xor(o[0][rg], 1), p1 = __shfl_xor(o[1][rg], 1);
        *(GAS unsigned*)(OG + tok * SW) = odd ? cvt_pk_bf16(p1, o[1][rg]) : cvt_pk_bf16(o[0][rg], p0); }
    __syncthreads();
}
constexpr size_t WS_SOG = WS_US + 128 * 1024, WS_SLSE = WS_US + 256 * 1024;
__device__ __forceinline__ void attn_sample_task(Frame& F, int task) {
    const int g = task % 3, sh = task / 3, sb = sh >> 2, hc = sh & 3, lane = F.lane;
    LAS float* qs = (LAS float*)(F.lds + F.wave * 2048);
    LAS float* ps = qs + 64;
    const int W = 128 << (2 * g), d = 1 << (2 * g);
    const float* cache = FIN(4 + g) + (size_t)sb * W * 512;
    const float* newkv = F.out + (g == 0 ? O_SKV0 : g == 1 ? O_SKV1 : O_SKV2) + ((size_t)(sb * W + W - 1) * 2) * 256;
    const bf16* Qs = (const bf16*)(F.ws + WS_Q) + (size_t)(MPR + sb) * AW + g * 256 + hc * 64;
    qs[lane] = bf2f(Qs[lane]);
    LDS_WAIT(); asm volatile("" ::: "memory");
    const float slope = alibi_slope(g, hc);
    float s0 = -3.0e38f, s1 = -3.0e38f, s2 = -3.0e38f;
#pragma unroll 1
    for (int sl = 0; sl < 3; ++sl) { const int j = lane + 64 * sl; float sc = -3.0e38f;
        if (j <= 128) { const float* kr = (j == 0) ? newkv + hc * 64 : cache + (size_t)(W - j * d) * 512 + hc * 64; f32x4 kk[16];
#pragma unroll
            for (int c = 0; c < 16; ++c) kk[c] = *(const GAS f32x4*)(kr + 4 * c);
            float dot = 0.f;
#pragma unroll
            for (int c = 0; c < 16; ++c) { const f32x4 qq = *(const LAS f32x4*)(qs + 4 * c); dot += (kk[c][0] * qq[0] + kk[c][1] * qq[1]) + (kk[c][2] * qq[2] + kk[c][3] * qq[3]); }
            sc = dot - slope * (float)(j * d); }
        s0 = (sl == 0) ? sc : s0; s1 = (sl == 1) ? sc : s1; s2 = (sl == 2) ? sc : s2; }
    const float m = wave_max(fmaxf(fmaxf(s0, s1), s2));
    const float p0 = __expf(s0 - m), p1 = __expf(s1 - m), p2 = __expf(s2 - m);
    const float den = wave_sum(p0 + p1 + p2);
    ps[lane] = p0; ps[64 + lane] = p1; ps[128 + lane] = p2;
    LDS_WAIT(); asm volatile("" ::: "memory");
    const int kg = lane >> 4, dc = lane & 15;
    f32x4 o = (f32x4){0.f, 0.f, 0.f, 0.f};
#pragma unroll 1
    for (int i0 = 0; i0 < 33; i0 += 11) { f32x4 vv[11]; float pj[11];
#pragma unroll
        for (int k = 0; k < 11; ++k) { const int j = 4 * (i0 + k) + kg; const bool ok = j <= 128; const int jj = ok ? j : 0;
            const float* vr = (jj == 0) ? newkv + 256 + hc * 64 : cache + (size_t)(W - jj * d) * 512 + 256 + hc * 64;
            vv[k] = *(const GAS f32x4*)(vr + 4 * dc); pj[k] = ok ? ps[jj] : 0.f; }
#pragma unroll
        for (int k = 0; k < 11; ++k) o += pj[k] * vv[k]; }
#pragma unroll
    for (int c = 0; c < 4; ++c) { o[c] += __shfl_xor(o[c], 16); o[c] += __shfl_xor(o[c], 32); }
    LDS_WAIT(); asm volatile("" ::: "memory");
    if (lane < 16) *(GAS f32x4*)((float*)(F.ws + WS_SOG) + (size_t)(sh * 3 + g) * 64 + 4 * dc) = o * (1.0f / den);
    if (lane == 0) ((float*)(F.ws + WS_SLSE))[sh * 3 + g] = m + __logf(den);
}
__device__ __forceinline__ void sample_mix(Frame& F) {
    const int gt = F.bid * (NWAVES * 64) + F.tid;
    if (gt < NSMP * 4 * 64) { const int sh = gt >> 6, dim = gt & 63, sb = sh >> 2, hc = sh & 3;
        const float lv = ((const float*)(F.ws + WS_SLSE))[sh * 3 + (F.lane % 3)];
        const float l0 = __shfl(lv, 0), l1 = __shfl(lv, 1), l2 = __shfl(lv, 2);
        const float mx = fmaxf(fmaxf(l0, l1), l2); const float w0 = __expf(l0 - mx), w1 = __expf(l1 - mx), w2 = __expf(l2 - mx);
        const float* og = (const float*)(F.ws + WS_SOG) + (size_t)sh * 3 * 64 + dim;
        const float ob = (w0 * og[0] + w1 * og[64] + w2 * og[128]) / (w0 + w1 + w2);
        ((bf16*)(F.ws + WS_OB))[(size_t)(MPR + sb) * SW + hc * 64 + dim] = (bf16)f2bf(ob); }
}

__device__ __forceinline__ void p5_combine(Frame& F) {
    const size_t gt = (size_t)F.bid * (NWAVES * 64) + F.tid, NT = (size_t)F.G * NWAVES * 64;
    const float* LSE = (const float*)(F.ws + WS_LSE); const GAS u32x2* OG = (const GAS u32x2*)(F.ws + WS_OG); bf16* OB = (bf16*)(F.ws + WS_OB);
    for (size_t e = gt; e < (size_t)MPR * 64; e += NT) { const size_t tok = e >> 6; const int hc = (int)(e >> 4) & 3;
        const float l0 = LSE[tok * 4 + hc], l1 = LSE[((size_t)MPR + tok) * 4 + hc], l2 = LSE[((size_t)2 * MPR + tok) * 4 + hc];
        const float mx = fmaxf(fmaxf(l0, l1), l2); const float w0 = __expf(l0 - mx), w1 = __expf(l1 - mx), w2 = __expf(l2 - mx); const float inv = 1.0f / (w0 + w1 + w2);
        const u32x2 aw = OG[e], bw = OG[(size_t)MPR * 64 + e], cw = OG[(size_t)2 * MPR * 64 + e];
        const f32x4 a = (f32x4){bflo(aw.x), bfhi(aw.x), bflo(aw.y), bfhi(aw.y)}, b = (f32x4){bflo(bw.x), bfhi(bw.x), bflo(bw.y), bfhi(bw.y)}, c = (f32x4){bflo(cw.x), bfhi(cw.x), bflo(cw.y), bfhi(cw.y)};
        const f32x4 o = (w0 * a + w1 * b + w2 * c) * inv;
        u32x2 pk; pk.x = cvt_pk_bf16(o[0], o[1]); pk.y = cvt_pk_bf16(o[2], o[3]);
        *(GAS u32x2*)(OB + e * 4) = pk; }
}
__device__ __forceinline__ void p5_carry(Frame& F, int g, int b) {
    const int p = F.lane;
    const float* sp = (const float*)(F.ws + WS_SSMP);
    const float ar = sp[SSMP_A32 / 4 + (g * 64 + p) * 2], ai = sp[SSMP_A32 / 4 + (g * 64 + p) * 2 + 1];
    const float* SST = (const float*)(F.ws + WS_SST) + ((size_t)g * 512 + b * 128) * 128; bf16* HS = (bf16*)(F.ws + WS_HS) + ((size_t)g * 512 + b * 128) * 128;
    float hr = 0.f, hi = 0.f;
    for (int cb = 0; cb < NCH; cb += 16) { float sr[16], si[16];
#pragma unroll
        for (int k = 0; k < 16; ++k) { sr[k] = SST[(size_t)(cb + k) * 128 + p]; si[k] = SST[(size_t)(cb + k) * 128 + 64 + p]; }
#pragma unroll
        for (int k = 0; k < 16; ++k) { HS[(size_t)(cb + k) * 128 + p] = (bf16)f2bf(hr); HS[(size_t)(cb + k) * 128 + 64 + p] = (bf16)f2bf(hi);
            const float nr = ar * hr - ai * hi + sr[k], ni = ar * hi + ai * hr + si[k]; hr = nr; hi = ni; } }
    F.out[O_PSR + (size_t)(b * 64 + g) * 64 + p] = hr; F.out[O_PSI + (size_t)(b * 64 + g) * 64 + p] = hi;
}
__device__ __forceinline__ void p5_sample_ssm(Frame& F, int sb, int g) {
    const int p = F.lane;
    const float* sp = (const float*)(F.ws + WS_SSMP);
    const float ar = sp[SSMP_A1 / 4 + (g * 64 + p) * 2], ai = sp[SSMP_A1 / 4 + (g * 64 + p) * 2 + 1];
    const float h0r = FIN(2)[(size_t)(sb * 64 + g) * 64 + p], h0i = FIN(3)[(size_t)(sb * 64 + g) * 64 + p];
    const float uval = ((const float*)(F.ws + WS_US))[(size_t)sb * DM + g * 16 + (p & 15)];
    float bur = 0.f, bui = 0.f;
#pragma unroll
    for (int c = 0; c < 16; ++c) { const float uc = __shfl(uval, c); const float* bb = sp + SSMP_BB / 4 + ((size_t)(g * 64 + p) * 16 + c) * 2; bur += bb[0] * uc; bui += bb[1] * uc; }
    const float hr = ar * h0r - ai * h0i + bur, hi = ar * h0i + ai * h0r + bui;
    F.out[O_SSR + (size_t)(sb * 64 + g) * 64 + p] = hr; F.out[O_SSI + (size_t)(sb * 64 + g) * 64 + p] = hi;
    float yv = 0.f;
#pragma unroll
    for (int co = 0; co < 16; ++co) { const float cr = FIN(17)[(size_t)(g * 16 + co) * 64 + p], ci = FIN(18)[(size_t)(g * 16 + co) * 64 + p];
        const float t = wave_sum(cr * hr - ci * hi); if (p == co) yv = t; }
    if (p < 16) { const float y = yv + FIN(19)[g * 16 + p] * uval; ((bf16*)(F.ws + WS_YSM))[(size_t)(MPR + sb) * DM + g * 16 + p] = (bf16)f2bf(gelu_tanh(y)); }
}

struct Sched2 { ge::StdSched a, b; int na;
    __device__ __forceinline__ bool seg(int i, ge::Seg& s) const { if (i < na) return a.seg(i, s); if (!b.seg(i - na, s)) return false; s.geo = 1; return true; } };
template <class EA, class EB> struct Epi2 { EA e0; EB e1;
    template <int AI_N = 2, int M_N = 4> __device__ __forceinline__ void run(const AccT& acc, const ge::Seg& u, int wr, int wc, int fr, int fq) const {
        if (u.geo == 0) e0.template run<AI_N, M_N>(acc, u, wr, wc, fr, fq); else e1.template run<AI_N, M_N>(acc, u, wr, wc, fr, fq); } };

constexpr int N_PHASES = 12;
__global__ void __launch_bounds__(NWAVES * 64, 2) fwd_kernel(Args args) {
    extern __shared__ __attribute__((aligned(16))) unsigned char lds_raw[];
    Frame F;
    F.lds = (LAS unsigned char*)lds_raw;
    F.tid = threadIdx.x; F.lane = F.tid & 63; F.wave = __builtin_amdgcn_readfirstlane(F.tid >> 6);
    F.G = gridDim.x; F.bid = blockIdx.x;
    F.a = &args; F.out = args.out; F.ws = args.ws;
    volatile LAS unsigned* MISC = (volatile LAS unsigned*)(F.lds + MISC_OFF);
    for (int u = F.tid; u < (LDS_BYTES - LDSCTL_OFF) / 4; u += NWAVES * 64) ((LAS unsigned*)(F.lds + LDSCTL_OFF))[u] = 0u;
    __syncthreads();
    const int lo = args.ph_lo, hi = args.ph_hi;
    const bool use_bar = (hi - lo) > 1;
    XcdBarrier bar; bar.bar = (unsigned*)(F.ws + WS_CTL) + CW_BAR; bar.x = 0; bar.st = nullptr;
    if (use_bar) bar = xcd_barrier_post((unsigned*)(F.ws + WS_CTL) + CW_BAR, MISC + 8);
#ifdef ONLY_PHASE
#define IN(k) ((k) == ONLY_PHASE)
#else
#define IN(k) (lo <= (k) && (k) < hi)
#endif
#define SEAM(k) do { if (IN(k) && IN((k) + 1)) xcd_barrier(bar); } while (0)
    bf16* XBF = (bf16*)(F.ws + WS_XBF); float* SSP = (float*)(F.ws + WS_SSP); bf16* HID = (bf16*)(F.ws + WS_HID);

    if (IN(0)) { p0_prologue(F); } SEAM(0);
    if (IN(1)) {
        ge::StdSched S; S.init(XBF, DM * 2, F.ws + WS_WGU1, DM * 2, MPR, 2 * FF, DM, F.G, F.bid);
        fill_rstd(F, S, (const float*)(F.ws + WS_SS0), 1);
        EpiGateUp E{(const LAS float*)(F.lds + RSTAB_OFF), HID}, Es{(const LAS float*)(F.lds + RSTAB_S_OFF), HID}; const ge::GeoDesc gd[1] = {{DM * 2, DM * 2, 0}};
        skinny_phase<false>(F, XBF, DM, F.ws + WS_WGU1, DM, 2 * FF, DM, Es);
        ge::gemm_phase<EpiGateUp, ge::StdSched, 1>(F.lds, S, E, gd);
        if (F.G == 256 && F.bid >= 128) bg_copy(F, BGO_P1 + (F.bid - 128) * BGW_T, BGO_P1 + (F.bid - 127) * BGW_T, F.wave, NWAVES);
    } SEAM(1);
    if (IN(2)) {
        ge::StdSched S; S.init(HID, FF * 2, F.ws + WS_WD1, FF * 2, MPR, DM, FF, F.G, F.bid);
        EpiResid<false> E{0.5f, XBF, SSP, nullptr, (float*)(F.ws + WS_SSPS)}; const ge::GeoDesc gd[1] = {{FF * 2, FF * 2, 0}};
        skinny_phase<true>(F, HID, FF, F.ws + WS_WD1, FF, DM, FF, E);
        if (F.G == 256 && F.bid < BG_NF) bg_copy(F, BGO_S2 + F.bid * BGW_S2, BGO_S2 + (F.bid + 1) * BGW_S2, F.wave, NWAVES);
        ge::gemm_phase<EpiResid<false>, ge::StdSched, 1>(F.lds, S, E, gd);
    } SEAM(2);
    if (IN(3)) {
        ge::StdSched S; S.init(XBF, DM * 2, F.ws + WS_WIN, DM * 2, MPR, NIN, DM, F.G, F.bid);
        fill_rstd(F, S, SSP, 16);
        EpiWin E{(const LAS float*)(F.lds + RSTAB_OFF), (bf16*)(F.ws + WS_U), (bf16*)(F.ws + WS_Q), (bf16*)(F.ws + WS_K), (bf16*)(F.ws + WS_V), (bf16*)(F.ws + WS_GA), (bf16*)(F.ws + WS_GB),
                 (float*)(F.ws + WS_US), FIN(22), FIN(23), F.out};
        EpiWin Es = E; Es.rs = (const LAS float*)(F.lds + RSTAB_S_OFF);
        const ge::GeoDesc gd[1] = {{DM * 2, DM * 2, 0}};
        skinny_phase<false>(F, XBF, DM, F.ws + WS_WIN, DM, NIN, DM, Es);
        ge::gemm_phase<EpiWin, ge::StdSched, 1>(F.lds, S, E, gd);
        if (F.G == 256 && F.bid >= 64) bg_copy(F, BGO_P3 + (F.bid - 64) * BGW_T, BGO_P3 + (F.bid - 63) * BGW_T, F.wave, NWAVES);
    } SEAM(3);
    const bool px = (F.G == 256) && IN(4) && IN(5) && IN(6);
    if (px) {
        if (F.bid < 128) {
            const int g = F.bid >> 1, pm = F.bid & 1;
            { StateSched S{(const char*)(F.ws + WS_U), (const char*)(F.ws + WS_W1T), F.G, F.bid}; EpiState E{(float*)(F.ws + WS_SST)};
              const ge::GeoDesc gd[1] = {{1024, 1024, 0}};
              ge::gemm_phase<EpiState, StateSched, 1>(F.lds, S, E, gd); }
            VM_WAIT(); __syncthreads();
            if (F.wave < 2) p5_carry(F, g, 2 * pm + F.wave);
            else if (F.wave < 5) attn_sample_task(F, F.bid * 3 + (F.wave - 2));
            else bg_copy(F, BGO_XS + F.bid * BGW_XS, BGO_XS + (F.bid + 1) * BGW_XS, F.wave - 5, 3);
            VM_WAIT(); __syncthreads();
            { SsmYSchedB S{(const char*)(F.ws + WS_HS), (const char*)(F.ws + WS_BH), (const char*)(F.ws + WS_U), (const char*)(F.ws + WS_KT), F.bid};
              EpiSsmY E{(bf16*)(F.ws + WS_YSM)};
              const ge::GeoDesc gd[2] = {{256, 256, 0}, {1024, 0, 1}};
              ge::gemm_phase<EpiSsmY, SsmYSchedB, 2>(F.lds, S, E, gd); }
        } else {
            for (int it = F.bid - 128; it < 768; it += 128) attn_item(F, it);
            for (int t = (F.bid - 128) * NWAVES + F.wave; t < NSMP * NG; t += 128 * NWAVES) p5_sample_ssm(F, t >> 6, t & 63);
            bg_copy(F, BGO_XA + (F.bid - 128) * BGW_XA, BGO_XA + (F.bid - 127) * BGW_XA, F.wave, NWAVES);
        }
    } else {
    if (IN(4)) {
        { StateSched S{(const char*)(F.ws + WS_U), (const char*)(F.ws + WS_W1T), F.G, F.bid}; EpiState E{(float*)(F.ws + WS_SST)};
          const ge::GeoDesc gd[1] = {{1024, 1024, 0}};
          ge::gemm_phase<EpiState, StateSched, 1>(F.lds, S, E, gd); }
        __syncthreads();
        for (int it = F.bid; it < 768; it += F.G) attn_item(F, it);
    } SEAM(4);
    if (IN(5)) {
        for (int t = F.bid * NWAVES + F.wave; t < NSMP * NG; t += F.G * NWAVES) p5_sample_ssm(F, t >> 6, t & 63);
        if (F.wave == 0) for (int u = F.bid; u < 256; u += F.G) p5_carry(F, u >> 2, u & 3);
        if (F.wave == 1 || F.wave == 2) for (int t = (F.wave - 1) * F.G + F.bid; t < NSMP * 4 * 3; t += 2 * F.G) attn_sample_task(F, t);
        if (F.G == 256 && F.wave >= 3) { if (F.bid < 128) bg_copy(F, BGO_XS + F.bid * BGW_XS, BGO_XS + (F.bid + 1) * BGW_XS, F.wave - 3, NWAVES - 3);
                                         else bg_copy(F, BGO_XA + (F.bid - 128) * BGW_XA, BGO_XA + (F.bid - 127) * BGW_XA, F.wave - 3, NWAVES - 3); }
    } SEAM(5);
    if (IN(6)) {
        SsmYSched S{(const char*)(F.ws + WS_HS), (const char*)(F.ws + WS_BH), (const char*)(F.ws + WS_U), (const char*)(F.ws + WS_KT), F.G, F.bid};
        EpiSsmY E{(bf16*)(F.ws + WS_YSM)};
        const ge::GeoDesc gd[2] = {{256, 256, 0}, {1024, 0, 1}};
        ge::gemm_phase<EpiSsmY, SsmYSched, 2>(F.lds, S, E, gd);
    }
    }
    SEAM(6);
    if (IN(7)) {
        p5_combine(F); sample_mix(F);
        ge::StdSched S; S.init(F.ws + WS_YSM, DM * 2, F.ws + WS_WGLU, DM * 2, MPR, DM, DM, F.G, F.bid);
        EpiElem<0> E{(const bf16*)(F.ws + WS_YSM), nullptr, (bf16*)(F.ws + WS_YA)}; const ge::GeoDesc gd[1] = {{DM * 2, DM * 2, 0}};
        skinny_phase<true>(F, F.ws + WS_YSM, DM, F.ws + WS_WGLU, DM, DM, DM, E);
        if (F.G == 256 && F.bid < BG_NF) bg_copy(F, BGO_S7 + F.bid * BGW_S7, BGO_S7 + (F.bid + 1) * BGW_S7, F.wave, NWAVES);
        ge::gemm_phase<EpiElem<0>, ge::StdSched, 1>(F.lds, S, E, gd);
    } SEAM(7);
    if (IN(8)) {
        ge::StdSched S0; S0.init(F.ws + WS_OB, SW * 2, F.ws + WS_WPB, SW * 2, MPR, DM, SW, F.G, F.bid);
        ge::StdSched S1; S1.init(F.ws + WS_YA, DM * 2, F.ws + WS_WPA, DM * 2, MPR, DM, DM, F.G, F.bid);
        EpiElem<1> E0{(const bf16*)(F.ws + WS_GB), nullptr, (bf16*)(F.ws + WS_TB)};
        EpiElem<2> E1{(const bf16*)(F.ws + WS_GA), (const bf16*)(F.ws + WS_TB), (bf16*)(F.ws + WS_YSM)};
        skinny_phase<true>(F, F.ws + WS_OB, SW, F.ws + WS_WPB, SW, DM, SW, E0);
        skinny_phase<true>(F, F.ws + WS_YA, DM, F.ws + WS_WPA, DM, DM, DM, E1);
        if (F.G == 256 && F.bid < BG_NF) bg_copy(F, BGO_S8 + F.bid * BGW_S8, BGO_S8 + (F.bid + 1) * BGW_S8, F.wave, NWAVES);
        int na = 0; { ge::Seg t; while (S0.seg(na, t)) ++na; }
        Sched2 S{S0, S1, na}; Epi2<EpiElem<1>, EpiElem<2> > E{E0, E1};
        const ge::GeoDesc gd[2] = {{SW * 2, SW * 2, 0}, {DM * 2, DM * 2, 0}};
        ge::gemm_phase<Epi2<EpiElem<1>, EpiElem<2> >, Sched2, 2>(F.lds, S, E, gd);
    } SEAM(8);
    if (IN(9)) {
        ge::StdSched S; S.init(F.ws + WS_YSM, DM * 2, F.ws + WS_WOUT, DM * 2, MPR, DM, DM, F.G, F.bid);
        EpiResid<false> E{1.0f, XBF, SSP, nullptr, (float*)(F.ws + WS_SSPS)}; const ge::GeoDesc gd[1] = {{DM * 2, DM * 2, 0}};
        skinny_phase<true>(F, F.ws + WS_YSM, DM, F.ws + WS_WOUT, DM, DM, DM, E);
        if (F.G == 256 && F.bid < BG_NF) bg_copy(F, BGO_S9 + F.bid * BGW_S9, BGO_S9 + (F.bid + 1) * BGW_S9, F.wave, NWAVES);
        ge::gemm_phase<EpiResid<false>, ge::StdSched, 1>(F.lds, S, E, gd);
    } SEAM(9);
    if (IN(10)) {
        ge::StdSched S; S.init(XBF, DM * 2, F.ws + WS_WGU2, DM * 2, MPR, 2 * FF, DM, F.G, F.bid);
        fill_rstd(F, S, SSP, 16);
        EpiGateUp E{(const LAS float*)(F.lds + RSTAB_OFF), HID}, Es{(const LAS float*)(F.lds + RSTAB_S_OFF), HID}; const ge::GeoDesc gd[1] = {{DM * 2, DM * 2, 0}};
        skinny_phase<false>(F, XBF, DM, F.ws + WS_WGU2, DM, 2 * FF, DM, Es);
        ge::gemm_phase<EpiGateUp, ge::StdSched, 1>(F.lds, S, E, gd);
        if (F.G == 256 && F.bid >= 128) bg_copy(F, BGO_P10 + (F.bid - 128) * BGW_T, BGO_P10 + (F.bid - 127) * BGW_T, F.wave, NWAVES);
    } SEAM(10);
    if (IN(11)) {
        ge::StdSched S; S.init(HID, FF * 2, F.ws + WS_WD2, FF * 2, MPR, DM, FF, F.G, F.bid);
        EpiResid<true> E{0.5f, XBF, nullptr, F.out, nullptr}; const ge::GeoDesc gd[1] = {{FF * 2, FF * 2, 0}};
        skinny_phase<true>(F, HID, FF, F.ws + WS_WD2, FF, DM, FF, E);
        if (F.G == 256 && F.bid < BG_NF) bg_copy(F, BGO_S11 + F.bid * BGW_S11, BGO_S11 + (F.bid + 1) * BGW_S11, F.wave, NWAVES);
        ge::gemm_phase<EpiResid<true>, ge::StdSched, 1>(F.lds, S, E, gd);
    }
#undef IN
#undef SEAM
}

#ifndef DBG_LAST_PHASE
#define DBG_LAST_PHASE 11
#endif
#ifndef MK_N_LAUNCHES
#define MK_N_LAUNCHES 1
#endif
extern "C" void kernel_launch(void* const* d_in, const int* in_sizes, int n_in, void* d_out, int out_size, void* d_ws, size_t ws_size, hipStream_t stream) {
    static int grid = 0;
    if (grid == 0) {
        if (n_in != 31 || (size_t)out_size != O_END || ws_size < WS_END) { fprintf(stderr, "kernel_launch: unexpected sizes: n_in %d out %d (want %zu) ws %zu (want >= %zu)\n", n_in, out_size, (size_t)O_END, ws_size, (size_t)WS_END); grid = -1; return; }
        int dev = 0, cus = 0, per_cu = 0;
        if (hipGetDevice(&dev) != hipSuccess || hipDeviceGetAttribute(&cus, hipDeviceAttributeMultiprocessorCount, dev) != hipSuccess) { grid = -1; return; }
        if (hipFuncSetAttribute((const void*)fwd_kernel, hipFuncAttributeMaxDynamicSharedMemorySize, LDS_BYTES) != hipSuccess) { fprintf(stderr, "kernel_launch: hipFuncSetAttribute failed\n"); grid = -1; return; }
        if (hipOccupancyMaxActiveBlocksPerMultiprocessor(&per_cu, (const void*)fwd_kernel, NWAVES * 64, LDS_BYTES) != hipSuccess || per_cu < 1) { fprintf(stderr, "kernel_launch: occupancy query says %d\n", per_cu); per_cu = 1; }
        (void)hipGetLastError();
        grid = cus;
    }
    if (grid < 0) return;
    (void)hipMemsetAsync((char*)d_ws + WS_CTL, 0, CTL_ZERO_BYTES, stream);
    Args a{};
    for (int i = 0; i < 31; ++i) a.in[i] = (const float*)d_in[i];
    a.out = (float*)d_out; a.ws = (unsigned char*)d_ws;
    if (MK_N_LAUNCHES == 1) { a.ph_lo = 0; a.ph_hi = N_PHASES; hipLaunchKernelGGL(fwd_kernel, dim3(grid), dim3(NWAVES * 64), LDS_BYTES, stream, a); }
    else for (int p = 0; p < DBG_LAST_PHASE + 1; ++p) { a.ph_lo = p; a.ph_hi = p + 1; hipLaunchKernelGGL(fwd_kernel, dim3(grid), dim3(NWAVES * 64), LDS_BYTES, stream, a); }
}
```

```cpp
#include <hip/hip_runtime.h>
#include <cstdio>
#include <cstdint>

#define LAS __attribute__((address_space(3)))
#define GAS __attribute__((address_space(1)))
typedef unsigned short bf16;
typedef short bf16x8 __attribute__((ext_vector_type(8)));
typedef short s16x4 __attribute__((ext_vector_type(4)));
typedef float f32x2 __attribute__((ext_vector_type(2)));
typedef float f32x4 __attribute__((ext_vector_type(4)));
typedef float f32x16 __attribute__((ext_vector_type(16)));
typedef unsigned u32x2 __attribute__((ext_vector_type(2)));
typedef unsigned u32x4 __attribute__((ext_vector_type(4)));

constexpr int DM = 1024, NBATCH = 4, SEQ = 4096, MPR = NBATCH * SEQ, NSMP = 32, MP = MPR + 256, FF = 2816, NIN = 5376;
constexpr int NG = 64, GC = 16, NPS = 64, CH = 32, NCH = SEQ / CH;
constexpr int HD = 64, AW = 768, SW = 256;
constexpr float RMS_EPS = 1e-6f;
constexpr int NWAVES = 8;

constexpr size_t O_YP = 0, O_YS = O_YP + (size_t)MPR * DM, O_PSR = O_YS + (size_t)NSMP * DM, O_PSI = O_PSR + 4 * 64 * 64,
                 O_PKV0 = O_PSI + 4 * 64 * 64, O_PKV1 = O_PKV0 + (size_t)4 * 128 * 512, O_PKV2 = O_PKV1 + (size_t)4 * 512 * 512,
                 O_SSR = O_PKV2 + (size_t)4 * 2048 * 512, O_SSI = O_SSR + 32 * 64 * 64, O_SKV0 = O_SSI + 32 * 64 * 64,
                 O_SKV1 = O_SKV0 + (size_t)32 * 128 * 512, O_SKV2 = O_SKV1 + (size_t)32 * 512 * 512, O_END = O_SKV2 + (size_t)32 * 2048 * 512;

constexpr size_t MiB = 1u << 20;
constexpr size_t WS_CTL = 0, CTL_ZERO_BYTES = 1 * MiB;
constexpr size_t WS_WGU1 = 1 * MiB;
constexpr size_t WS_WD1  = 12 * MiB;
constexpr size_t WS_WIN  = 18 * MiB;
constexpr size_t WS_WGLU = 29 * MiB, WS_WPA = 31 * MiB, WS_WOUT = 33 * MiB;
constexpr size_t WS_WPB  = 35 * MiB;
constexpr size_t WS_WGU2 = 36 * MiB, WS_WD2 = 47 * MiB;
constexpr size_t WS_KT   = 53 * MiB;
constexpr size_t KT_STRIDE = 47 * 512;
constexpr size_t WS_BH   = 55 * MiB;
constexpr size_t WS_W1T  = 63 * MiB;
constexpr size_t WS_SSMP = 72 * MiB;
constexpr size_t SSMP_A32 = 0, SSMP_A1 = 64 * 64 * 2 * 4, SSMP_BB = 2 * 64 * 64 * 2 * 4;
constexpr size_t WS_XBF  = 73 * MiB;
constexpr size_t WS_SS0  = 106 * MiB;
constexpr size_t WS_SSP  = 107 * MiB;
constexpr size_t WS_HID  = 109 * MiB;
constexpr size_t WS_OG   = WS_HID;
constexpr size_t WS_LSE  = WS_HID + 48 * MiB;
constexpr size_t WS_YA   = WS_HID + 49 * MiB;
constexpr size_t WS_XR   = 199 * MiB;
constexpr size_t WS_U    = 264 * MiB;
constexpr size_t WS_HS   = 296 * MiB;
constexpr size_t WS_SST  = 304 * MiB;
constexpr size_t WS_Q    = 320 * MiB, WS_K = 345 * MiB, WS_V = 370 * MiB;
constexpr size_t WS_TB   = WS_Q;
constexpr size_t WS_GA   = 395 * MiB, WS_GB = 428 * MiB;
constexpr size_t WS_YSM  = 461 * MiB;
constexpr size_t WS_OB   = 494 * MiB;
constexpr size_t WS_US   = 503 * MiB;
constexpr size_t WS_END  = 504 * MiB;
constexpr size_t WS_SSPS = WS_US + 384 * 1024;
static_assert(WS_U + (size_t)NG * 512 * 512 * 2 <= WS_HS && WS_HS + (size_t)NG * 512 * 128 * 2 <= WS_SST && WS_SST + (size_t)NG * 512 * 128 * 4 <= WS_Q, "ws map 0");
static_assert(WS_BH + (size_t)NG * 512 * 128 * 2 <= WS_W1T && WS_OG + (size_t)3 * MPR * SW * 4 <= WS_LSE && WS_LSE + (size_t)3 * MPR * 16 <= WS_YA && WS_US + (size_t)NSMP * DM * 4 <= WS_END, "ws map 00");
static_assert(WS_HID + (size_t)MP * FF * 2 <= WS_XR && WS_YA + (size_t)MP * DM * 2 <= WS_XR && WS_XR + (size_t)MP * DM * 4 <= WS_U, "ws map");
static_assert(WS_Q + (size_t)MP * AW * 2 <= WS_K && WS_V + (size_t)MP * AW * 2 <= WS_GA && WS_TB + (size_t)MP * DM * 2 <= WS_V, "ws map 2");
static_assert(WS_GA + (size_t)MP * DM * 2 <= WS_GB && WS_GB + (size_t)MP * DM * 2 <= WS_YSM && WS_YSM + (size_t)MP * DM * 2 <= WS_OB && WS_OB + (size_t)MP * SW * 2 <= WS_US, "ws map 3");
static_assert(WS_XBF + (size_t)MP * DM * 2 <= WS_SS0 && WS_SS0 + (size_t)MP * 4 <= WS_SSP && WS_SSP + (size_t)MP * 64 <= WS_HID, "ws map 4");
static_assert(WS_KT + 64 * KT_STRIDE <= WS_BH && WS_W1T + 64 * 128 * 1024 + 256 * 1024 <= WS_SSMP, "ws map 5");

constexpr int CW_BAR = 4096;

constexpr int RING_BYTES = 131072;
constexpr int LDSCTL_OFF = RING_BYTES, MISC_OFF = LDSCTL_OFF + 320;
constexpr int LDS_BYTES = 147456;

typedef GAS unsigned gu32;
#define LDS_WAIT() asm volatile("s_waitcnt lgkmcnt(0)" ::: "memory")
#define VM_WAIT() asm volatile("s_waitcnt vmcnt(0)" ::: "memory")
__device__ __forceinline__ unsigned f2bf(float f) { unsigned u = __builtin_bit_cast(unsigned, f); return (u + 0x7fffu + ((u >> 16) & 1u)) >> 16; }
__device__ __forceinline__ unsigned pk2(float lo, float hi) { return f2bf(lo) | (f2bf(hi) << 16); }
__device__ __forceinline__ float bf2f(unsigned short b) { return __builtin_bit_cast(float, (unsigned)b << 16); }
__device__ __forceinline__ float bflo(unsigned w) { return __builtin_bit_cast(float, w << 16); }
__device__ __forceinline__ float bfhi(unsigned w) { return __builtin_bit_cast(float, w & 0xffff0000u); }
typedef __bf16 bf16x2_t __attribute__((ext_vector_type(2)));
__device__ __forceinline__ unsigned cvt_pk_bf16(float lo, float hi) { const f32x2 v = {lo, hi}; const bf16x2_t b = __builtin_convertvector(v, bf16x2_t); return __builtin_bit_cast(unsigned, b); }
__device__ __forceinline__ float fast_rcp(float x) { return __builtin_amdgcn_rcpf(x); }
__device__ __forceinline__ float fast_exp2(float x) { return __builtin_amdgcn_exp2f(x); }
__device__ __forceinline__ float sigmoidf_(float x) { return fast_rcp(1.0f + fast_exp2(-1.4426950408889634f * x)); }
__device__ __forceinline__ float gelu_tanh(float x) {
    const float u = 0.7978845608028654f * (x + 0.044715f * x * x * x);
    return x * sigmoidf_(2.0f * u);
}

#define XB_TMO      128
#define XB_XCNT(j)  (256  + 64 * (j))
#define XB_XSUB(j)  (1280 + 64 * (j))
#define XB_XGEN(j)  (2304 + 64 * (j))
#define XB_TOP      3328
#define XB_TOPGEN   3392
#define XCD_BAR_WORDS 3456
#define XB_SPIN_CAP (1u << 18)
__device__ __forceinline__ unsigned xb_ld(unsigned* p)              { return __hip_atomic_load(p, __ATOMIC_RELAXED, __HIP_MEMORY_SCOPE_AGENT); }
__device__ __forceinline__ unsigned xb_add(unsigned* p, unsigned v) { return __hip_atomic_fetch_add(p, v, __ATOMIC_RELAXED, __HIP_MEMORY_SCOPE_AGENT); }
__device__ __forceinline__ unsigned xb_xcc_id() { return (unsigned)__builtin_amdgcn_s_getreg((3 << 11) | 20) & 0xFu; }
#define XB_SPIN(cond, bar) do { unsigned _sp = 0; while (cond) { __builtin_amdgcn_s_sleep(1); \
    if ((++_sp & 255u) == 0u) { if (xb_ld(&(bar)[XB_TMO])) break; if (_sp > XB_SPIN_CAP) { atomicAdd(&(bar)[XB_TMO], 1u); break; } } } } while (0)
struct XcdBarrier { unsigned* bar; unsigned x; volatile LAS unsigned* st; };
__device__ __forceinline__ XcdBarrier xcd_barrier_post(unsigned* bar, volatile LAS unsigned* st) {
    XcdBarrier b; b.bar = bar; b.x = xb_xcc_id(); b.st = st;
    if (threadIdx.x == 0) (void)xb_add(&bar[XB_XCNT(b.x)], 1u);
    return b;
}
__device__ __forceinline__ void xcd_barrier_complete(unsigned* bar, unsigned x, unsigned& nloc, unsigned& nx) {
    const unsigned G = gridDim.x * gridDim.y * gridDim.z;
    unsigned sum, cnt, mine, sp = 0u;
    for (;;) {
        sum = 0u; cnt = 0u; mine = 0u;
#pragma unroll
        for (unsigned j = 0; j < 16; ++j) { const unsigned c = xb_ld(&bar[XB_XCNT(j)]); sum += c; cnt += (c > 0u) ? 1u : 0u; mine = (j == x) ? c : mine; }
        if (sum == G) break;
        __builtin_amdgcn_s_sleep(1);
        if ((++sp & 255u) == 0u) { if (xb_ld(&bar[XB_TMO])) break; if (sp > XB_SPIN_CAP) { atomicAdd(&bar[XB_TMO], 1u); break; } }
    }
    nloc = mine > 0u ? mine : 1u; nx = cnt > 0u ? cnt : 1u;
}
__device__ __forceinline__ void xcd_barrier(const XcdBarrier& b) {
    asm volatile("s_waitcnt vmcnt(0)" ::: "memory");
    __syncthreads();
    if (threadIdx.x == 0) {
        unsigned* bar = b.bar;
        __builtin_amdgcn_s_waitcnt(0);
        unsigned nloc = b.st[0], nx = b.st[1];
        if (nloc == 0u) { xcd_barrier_complete(bar, b.x, nloc, nx); b.st[0] = nloc; b.st[1] = nx; }
        const unsigned old = xb_add(&bar[XB_XSUB(b.x)], 1u);
        const unsigned gen = old / nloc;
        if (old + 1u == (gen + 1u) * nloc) {
            __builtin_amdgcn_fence(__ATOMIC_RELEASE, "agent");
            asm volatile("s_waitcnt vmcnt(0)" ::: "memory");
            const unsigned og = xb_add(&bar[XB_TOP], 1u);
            const unsigned tg = og / nx;
            if (og + 1u == (tg + 1u) * nx) xb_add(&bar[XB_TOPGEN], 1u);
            else XB_SPIN(xb_ld(&bar[XB_TOPGEN]) == tg, bar);
            __builtin_amdgcn_fence(__ATOMIC_ACQUIRE, "agent");
            xb_add(&bar[XB_XGEN(b.x)], 1u);
            asm volatile("s_waitcnt vmcnt(0)" ::: "memory");
        } else {
            XB_SPIN(xb_ld(&bar[XB_XGEN(b.x)]) == gen, bar);
            __builtin_amdgcn_fence(__ATOMIC_ACQUIRE, "agent");
            asm volatile("s_waitcnt vmcnt(0)" ::: "memory");
        }
    }
    __syncthreads();
}

namespace ge {
constexpr int BM = 256, BK = 64, HALF = 128, HTB = HALF * BK * 2;
__host__ __device__ __forceinline__ int lds_byte(int r, int c) { const int st = (r >> 4) * 2 + (c >> 5), rr = r & 15, cc = c & 31, ob = rr * 64 + cc * 2; return st * 1024 + (ob ^ (((ob >> 9) & 1) << 5)); }
__host__ __device__ __forceinline__ void stage_rc(int b, int& R, int& C) { const int st = b / 1024, sb = b % 1024, swz = sb ^ (((sb >> 9) & 1) << 5); R = (st >> 1) * 16 + swz / 64; C = (st & 1) * 32 + (swz % 64) / 2; }
__host__ __device__ __forceinline__ int perm32(int rho) { const int n = rho >> 4, i = rho & 15; return 8 * (i >> 2) + 4 * n + (i & 3); }

struct Seg { const char* A; const char* B; int nt, flags, geo, pm, pn, aux, bjmask; };
struct GeoDesc { int lda, ldb, toep, bdup; };

template <class Epi, class Sched, int NGEO, bool DRAIN = false>
__device__ __forceinline__ void gemm_phase(LAS unsigned char* lds, const Sched& S, const Epi& E, const GeoDesc (&gd)[NGEO]) {
    const int tid = threadIdx.x, wid = __builtin_amdgcn_readfirstlane(tid >> 6), lane = tid & 63, wr = wid >> 2, wc = wid & 3, fr = lane & 15, fq = lane >> 4;
    unsigned vA[NGEO][2], vB[NGEO][2]; int kstB[NGEO], hsA[NGEO], hsB[NGEO];
#pragma unroll
    for (int g = 0; g < NGEO; ++g) {
#pragma unroll
        for (int i = 0; i < 2; ++i) { int R, C; stage_rc(tid * 16 + i * 8192, R, C); const int Rb = (R & ~31) + perm32(R & 31);
            vA[g][i] = (unsigned)(R * gd[g].lda + C * 2);
            vB[g][i] = gd[g].toep ? (unsigned)((((Rb >> 4) - (C >> 4) + 15) * 256 + (Rb & 15) * 16 + (C & 15)) * 2) : (unsigned)(Rb * gd[g].ldb + C * 2); }
        kstB[g] = gd[g].toep ? -2048 : 128; hsA[g] = HALF * gd[g].lda; hsB[g] = gd[g].toep ? 4096 : (gd[g].bdup ? 0 : HALF * gd[g].ldb);
    }
    const unsigned ldsw = (unsigned)wid * 1024u;
    const int aoff = lds_byte(wr * 64 + fr, fq * 8), boff = lds_byte(wc * 32 + fr, fq * 8);
#define GE_SA(b, h) (((b) * 2 + (h)) * HTB)
#define GE_SB(b, h) ((4 + (b) * 2 + (h)) * HTB)
#define GE_VA(g, i) (NGEO == 1 ? vA[0][i] : ((g) ? vA[NGEO - 1][i] : vA[0][i]))
#define GE_VB(g, i) (NGEO == 1 ? vB[0][i] : ((g) ? vB[NGEO - 1][i] : vB[0][i]))
#define GE_KSB(g) (NGEO == 1 ? kstB[0] : ((g) ? kstB[NGEO - 1] : kstB[0]))
#define GE_HSA(g) (NGEO == 1 ? hsA[0] : ((g) ? hsA[NGEO - 1] : hsA[0]))
#define GE_HSB(g) (NGEO == 1 ? hsB[0] : ((g) ? hsB[NGEO - 1] : hsB[0]))
#define GE_STAGE(bufoff, gbase, v0, v1) do { \
        __builtin_amdgcn_global_load_lds((const unsigned*)((const char*)(gbase) + (v0)), (LAS unsigned*)(lds + (bufoff) + ldsw), 16, 0, 0); \
        __builtin_amdgcn_global_load_lds((const unsigned*)((const char*)(gbase) + (v1)), (LAS unsigned*)(lds + (bufoff) + ldsw + 8192), 16, 0, 0); } while (0)
#define GE_STAGE_A(bufoff, gbase, g) GE_STAGE(bufoff, gbase, GE_VA(g, 0), GE_VA(g, 1))
#define GE_STAGE_B(bufoff, gbase, g) GE_STAGE(bufoff, gbase, GE_VB(g, 0), GE_VB(g, 1))
#define GE_LDA(dst, b, h) do { _Pragma("unroll") for (int m = 0; m < 4; ++m) _Pragma("unroll") for (int k = 0; k < 2; ++k) dst[m][k] = *(const LAS bf16x8*)(lds + GE_SA(b, h) + aoff + m * 2048 + k * 1024); } while (0)
#define GE_LDB(dst, b, h) do { _Pragma("unroll") for (int n = 0; n < 2; ++n) _Pragma("unroll") for (int k = 0; k < 2; ++k) dst[n][k] = *(const LAS bf16x8*)(lds + GE_SB(b, h) + boff + n * 2048 + k * 1024); } while (0)
#define GE_MMA(ai, bj, At, Bt) do { __builtin_amdgcn_s_setprio(1); _Pragma("unroll") for (int m = 0; m < 4; ++m) _Pragma("unroll") for (int n = 0; n < 2; ++n) _Pragma("unroll") for (int k = 0; k < 2; ++k) \
        acc[ai][bj][m][n] = __builtin_amdgcn_mfma_f32_16x16x32_bf16(Bt[n][k], At[m][k], acc[ai][bj][m][n], 0, 0, 0); __builtin_amdgcn_s_setprio(0); } while (0)
#define GE_WAIT_V(n) asm volatile("s_waitcnt vmcnt(" #n ")" ::: "memory")
#define GE_WAIT_L(n) asm volatile("s_waitcnt lgkmcnt(" #n ")" ::: "memory")
#define GE_BAR __builtin_amdgcn_s_barrier()
#define GE_SCHED __builtin_amdgcn_sched_barrier(0)
    Seg cur, nxt; int si = 0;
    if (!S.seg(0, cur)) return;
    f32x4 acc[2][2][4][2];
#pragma unroll
    for (int a = 0; a < 2; ++a)
#pragma unroll
        for (int b = 0; b < 2; ++b)
#pragma unroll
            for (int m = 0; m < 4; ++m)
#pragma unroll
                for (int n = 0; n < 2; ++n) acc[a][b][m][n] = (f32x4){0.f, 0.f, 0.f, 0.f};
    bf16x8 At[4][2], B0[2][2], B1[2][2];
    const char* cA = cur.A; const char* cB = cur.B; int cg = cur.geo;
    {
        GE_STAGE_B(GE_SB(0, 0), cB, cg); GE_STAGE_B(GE_SB(0, 1), cB + GE_HSB(cg), cg); GE_STAGE_A(GE_SA(0, 0), cA, cg); GE_STAGE_A(GE_SA(0, 1), cA + GE_HSA(cg), cg);
        if (wr == 1) GE_BAR;
        GE_WAIT_V(2); GE_BAR;
        GE_STAGE_B(GE_SB(1, 0), cB + GE_KSB(cg), cg); GE_STAGE_A(GE_SA(1, 0), cA + 128, cg); GE_STAGE_B(GE_SB(1, 1), cB + GE_HSB(cg) + GE_KSB(cg), cg);
        GE_WAIT_V(6); GE_BAR;
    }
    for (;;) {
        const bool has_next = S.seg(si + 1, nxt);
        const char* nA = has_next ? nxt.A : cA; const char* nB = has_next ? nxt.B : cB; const int ng = has_next ? nxt.geo : cg;
        const int nt = cur.nt;
        for (int t = 0; t < nt; t += 2) {
            const bool last = (t == nt - 2);
            const int g2 = last ? ng : cg;
            const char* a1 = cA + (size_t)(t + 1) * 128;
            const char* a2 = last ? nA : cA + (size_t)(t + 2) * 128;
            const char* b2 = last ? nB : cB + (long)(t + 2) * GE_KSB(cg);
            const char* a3 = a2 + 128; const char* b3 = b2 + GE_KSB(g2);
            GE_LDB(B0, 0, 0); GE_LDB(B1, 0, 1); GE_SCHED; GE_LDA(At, 0, 0); GE_STAGE_A(GE_SA(1, 1), a1 + GE_HSA(cg), cg);
            GE_WAIT_V(8); GE_WAIT_L(0); GE_BAR; GE_MMA(0, 0, At, B0); GE_MMA(0, 1, At, B1); GE_BAR; GE_SCHED;
            GE_LDA(At, 0, 1); GE_STAGE_B(GE_SB(0, 0), b2, g2); GE_STAGE_B(GE_SB(0, 1), b2 + GE_HSB(g2), g2); GE_STAGE_A(GE_SA(0, 0), a2, g2);
            GE_WAIT_V(8); GE_WAIT_L(0); GE_BAR; GE_MMA(1, 0, At, B0); GE_MMA(1, 1, At, B1); GE_BAR; GE_SCHED;
            GE_LDB(B0, 1, 0); GE_LDB(B1, 1, 1); GE_SCHED; GE_LDA(At, 1, 0); GE_STAGE_A(GE_SA(0, 1), a2 + GE_HSA(g2), g2);
            GE_WAIT_V(8); GE_WAIT_L(0); GE_BAR; GE_MMA(0, 0, At, B0); GE_MMA(0, 1, At, B1); GE_BAR; GE_SCHED;
            GE_LDA(At, 1, 1); GE_STAGE_B(GE_SB(1, 0), b3, g2); GE_STAGE_B(GE_SB(1, 1), b3 + GE_HSB(g2), g2); GE_STAGE_A(GE_SA(1, 0), a3, g2);
            GE_WAIT_V(8); GE_WAIT_L(0); GE_BAR; GE_MMA(1, 0, At, B0); GE_MMA(1, 1, At, B1); GE_BAR; GE_SCHED;
        }
        const bool epi = (cur.flags & 1) != 0;
        if (epi) {
            if (wr == 0) GE_BAR;
            if (!(DRAIN && !has_next)) E.template run<2, 4>(acc, cur, wr, wc, fr, fq);
        }
        if (!has_next) break;
        if (epi) {
#pragma unroll
            for (int a = 0; a < 2; ++a)
#pragma unroll
                for (int b = 0; b < 2; ++b)
#pragma unroll
                    for (int m = 0; m < 4; ++m)
#pragma unroll
                        for (int n = 0; n < 2; ++n) acc[a][b][m][n] = (f32x4){0.f, 0.f, 0.f, 0.f};
        }
        cur = nxt; cA = nA; cB = nB; cg = ng; ++si;
        if (epi) { if (wr == 1) GE_BAR; }
    }
    GE_WAIT_V(0);
    GE_BAR;
    if constexpr (DRAIN) E.drain(acc, cur, wr, wc, fr, fq, lds);
#undef GE_SA
#undef GE_SB
#undef GE_VA
#undef GE_VB
#undef GE_KSB
#undef GE_HSA
#undef GE_HSB
#undef GE_STAGE
#undef GE_STAGE_A
#undef GE_STAGE_B
#undef GE_LDA
#undef GE_LDB
#undef GE_MMA
#undef GE_WAIT_V
#undef GE_WAIT_L
#undef GE_BAR
#undef GE_SCHED
}

struct StdSched {
    const char* A; const char* B; size_t atile, btile; int nM, nN, nt, nwg, G, c;
    __device__ void init(const void* A_, int lda, const void* B_, int ldb, int M, int N, int K, int G_, int c_) {
        A = (const char*)A_; B = (const char*)B_; atile = (size_t)BM * lda; btile = (size_t)BM * ldb; nM = M / BM; nN = N / BM; nt = K / BK; nwg = nM * nN; G = G_; c = c_; }
    __device__ __forceinline__ bool seg(int i, Seg& s) const {
        const long L = (long)i * G + c; if (L >= nwg) return false;
        int wgid = (int)L; { const int q = nwg / 8, r = nwg % 8, xcd = wgid % 8, off = wgid / 8; wgid = (xcd < r ? xcd * (q + 1) : r * (q + 1) + (xcd - r) * q) + off; }
        const int nig = 4 * nN, gid = wgid / nig, fm = gid * 4, gsz = (nM - fm) < 4 ? (nM - fm) : 4;
        const int pm = fm + ((wgid % nig) % gsz), pn = (wgid % nig) / gsz;
        s.A = A + (size_t)pm * atile; s.B = B + (size_t)pn * btile; s.nt = nt; s.flags = 1; s.geo = 0; s.pm = pm; s.pn = pn; s.aux = i; s.bjmask = 3; return true;
    }
};
}

struct Args { const float* in[31]; float* out; unsigned char* ws; int ph_lo, ph_hi; };
struct Frame {
    LAS unsigned char* lds;
    int tid, lane, wave, G, bid;
    const Args* a;
    float* out;
    unsigned char* ws;
};
#define FIN(k) (F.a->in[k])
__device__ __forceinline__ float wave_sum(float v) {
#pragma unroll
    for (int o = 1; o < 64; o <<= 1) v += __shfl_xor(v, o);
    return v;
}
__device__ __forceinline__ float wave_max(float v) {
#pragma unroll
    for (int o = 1; o < 64; o <<= 1) v = fmaxf(v, __shfl_xor(v, o));
    return v;
}

constexpr int KVR0 = 32 * 127, KVR1 = KVR0 + 32 * 511, KVNR = KVR1 + 32 * 2047;
constexpr int BGW_P0 = 9, BGW_T = 24, BGW_XS = 4, BGW_XA = 5;
constexpr int BGW_S2 = 6, BGW_S7 = 4, BGW_S8 = 5, BGW_S9 = 4, BGW_S11 = 6, BG_NF = 224;
constexpr int BGO_P0 = 0, BGO_P1 = BGO_P0 + 256 * BGW_P0, BGO_P3 = BGO_P1 + 128 * BGW_T, BGO_XS = BGO_P3 + 192 * BGW_T, BGO_XA = BGO_XS + 128 * BGW_XS,
              BGO_P10 = BGO_XA + 128 * BGW_XA, BGO_S2 = BGO_P10 + 128 * BGW_T, BGO_S7 = BGO_S2 + BG_NF * BGW_S2, BGO_S8 = BGO_S7 + BG_NF * BGW_S7,
              BGO_S9 = BGO_S8 + BG_NF * BGW_S8, BGO_S11 = BGO_S9 + BG_NF * BGW_S9, BGW_TOT = BGO_S11 + BG_NF * BGW_S11;
__device__ __forceinline__ void kv_row_ptrs(Frame& F, int rho, const GAS f32x4*& src, GAS f32x4*& dst) {
    const int g = rho < KVR0 ? 0 : (rho < KVR1 ? 1 : 2);
    const int e = rho - (g == 0 ? 0 : (g == 1 ? KVR0 : KVR1)), Wm1 = (128 << (2 * g)) - 1, sb = e / Wm1, rr = e - sb * Wm1;
    const size_t ro = ((size_t)sb * (Wm1 + 1) + rr) * 128;
    src = (const GAS f32x4*)FIN(4 + g) + ro + 128; dst = (GAS f32x4*)(F.out + (g == 0 ? O_SKV0 : g == 1 ? O_SKV1 : O_SKV2)) + ro;
}
__device__ __forceinline__ void bg_copy(Frame& F, int wlo, int whi, int rank, int nw) {
    const int r_lo = (int)((long)KVNR * wlo / BGW_TOT), r_hi = (int)((long)KVNR * whi / BGW_TOT);
    for (int r0 = r_lo + 8 * rank; r0 < r_hi; r0 += 8 * nw) {
        f32x4 t[16]; GAS f32x4* dp[8];
#pragma unroll
        for (int k = 0; k < 8; ++k) { const int rho = (r0 + k < r_hi) ? r0 + k : r_lo; const GAS f32x4* sp; kv_row_ptrs(F, rho, sp, dp[k]); if (r0 + k >= r_hi) dp[k] = nullptr;
            t[2 * k] = __builtin_nontemporal_load(sp + F.lane); t[2 * k + 1] = __builtin_nontemporal_load(sp + 64 + F.lane); }
#pragma unroll
        for (int k = 0; k < 8; ++k) if (dp[k]) { __builtin_nontemporal_store(t[2 * k], dp[k] + F.lane); __builtin_nontemporal_store(t[2 * k + 1], dp[k] + 64 + F.lane); }
    }
}


__device__ __forceinline__ void p0_transpose_item(const float* W, int K, int N, bf16* WT, int drow0, LAS float* scr, int k0, int n0, const float* scale, int lane) {
    float wv[32];
#pragma unroll
    for (int i = 0; i < 32; ++i) { const int kk = 2 * i + (lane >> 5); wv[i] = __builtin_nontemporal_load(W + (size_t)(k0 + kk) * N + n0 + (lane & 31)); }
    if (scale) {
#pragma unroll
        for (int i = 0; i < 32; ++i) wv[i] *= scale[k0 + 2 * i + (lane >> 5)];
    }
#pragma unroll
    for (int i = 0; i < 32; ++i) scr[(2 * i + (lane >> 5)) * 33 + (lane & 31)] = wv[i];
    LDS_WAIT(); asm volatile("" ::: "memory");
    const int c = lane & 7;
#pragma unroll
    for (int j = 0; j < 4; ++j) { const int n = (lane >> 3) + 8 * j; const LAS float* s = scr + (8 * c) * 33 + n;
        u32x4 o; o.x = pk2(s[0 * 33], s[1 * 33]); o.y = pk2(s[2 * 33], s[3 * 33]); o.z = pk2(s[4 * 33], s[5 * 33]); o.w = pk2(s[6 * 33], s[7 * 33]);
        *(GAS u32x4*)(WT + (size_t)(drow0 + n) * K + k0 + 8 * c) = o; }
    LDS_WAIT(); asm volatile("" ::: "memory");
}
__device__ __forceinline__ int rmap_ident(int n0) { return n0; }
__device__ __forceinline__ int rmap_gate(int n0) { return 256 * (n0 >> 7) + (n0 & 127); }
__device__ __forceinline__ int rmap_up(int n0) { return 256 * (n0 >> 7) + 128 + (n0 & 127); }
__device__ __forceinline__ int rmap_win(int n0) { const int cl = n0 & 255; return (n0 & ~255) + 128 * ((cl & 63) >> 5) + 32 * (cl >> 6); }

__device__ __forceinline__ void sincos_rev(float r, float& s, float& c) {
    const float q = rintf(4.0f * r); const float f = r - 0.25f * q;
    const float x = f * 6.283185307179586f, z = x * x;
    const float sp = x + x * z * (-1.6666654611e-1f + z * (8.3321608736e-3f + z * (-1.9515295891e-4f)));
    const float cp = 1.0f - 0.5f * z + z * z * (4.166664568298827e-2f + z * (-1.388731625493765e-3f + z * 2.443315711809948e-5f));
    const int qi = ((int)q) & 3;
    s = (qi == 0) ? sp : (qi == 1) ? cp : (qi == 2) ? -sp : -cp;
    c = (qi == 0) ? cp : (qi == 1) ? -sp : (qi == 2) ? -cp : sp;
}
struct SsmP { float a, rb, fr, fi; };
__device__ __forceinline__ SsmP ssm_param(const Frame& F, int g, int p) {
    const float lr = fminf(FIN(13)[g * 64 + p], -1e-4f), li = FIN(14)[g * 64 + p];
    const float dt = __expf(FIN(20)[g]);
    SsmP o; o.a = lr * dt; const float b = li * dt; o.rb = b * 0.15915494309189535f;
    float s, c; sincos_rev(o.rb, s, c);
    const float a = o.a;
    const float em1 = (fabsf(a) < 0.1f) ? a * (1.0f + a * (0.5f + a * (0.16666667f + a * (0.041666668f + a * (0.0083333338f + a * 0.0013888889f))))) : (__expf(a) - 1.0f);
    float sh, chh; sincos_rev(0.5f * o.rb, sh, chh);
    const float cm1 = -2.0f * sh * sh;
    const float nr = em1 * c + cm1, ni = (em1 + 1.0f) * s;
    const float den = lr * lr + li * li;
    o.fr = (nr * lr + ni * li) / den; o.fi = (ni * lr - nr * li) / den;
    return o;
}
__device__ __forceinline__ void ssm_pow(const SsmP& P, int k, float& re, float& im) {
    const float mag = __expf(P.a * (float)k); float s, c; sincos_rev(P.rb * (float)k, s, c); re = mag * c; im = mag * s;
}
__device__ __forceinline__ void p0_ssm_task(const Frame& F, int g, int j, LAS float* scr) {
    const int lane = F.lane, p = lane;
    const SsmP P = ssm_param(F, g, p);
    const float* bre = FIN(15) + (size_t)(g * 64 + p) * 16; const float* bim = FIN(16) + (size_t)(g * 64 + p) * 16;
    float bbr[16], bbi[16];
#pragma unroll
    for (int c = 0; c < 16; ++c) { const float br = bre[c], bi = bim[c]; bbr[c] = P.fr * br - P.fi * bi; bbi[c] = P.fr * bi + P.fi * br; }
    bf16* KT = (bf16*)(F.ws + WS_KT) + (size_t)g * (KT_STRIDE / 2);
    bf16* BH = (bf16*)(F.ws + WS_BH) + (size_t)g * 512 * 128;
    bf16* W1T = (bf16*)(F.ws + WS_W1T) + (size_t)g * 128 * 512;
    { float ar, ai; ssm_pow(P, j, ar, ai);
#pragma unroll
      for (int c = 0; c < 16; ++c) { scr[p * 16 + c] = ar * bbr[c] - ai * bbi[c]; scr[1024 + p * 16 + c] = ar * bbi[c] + ai * bbr[c]; }
      LDS_WAIT(); asm volatile("" ::: "memory");
      const int co = lane >> 2, ci = 4 * (lane & 3);
      const float* cre = FIN(17) + (size_t)(g * 16 + co) * 64; const float* cim = FIN(18) + (size_t)(g * 16 + co) * 64;
      f32x4 acc = (f32x4){0.f, 0.f, 0.f, 0.f};
      for (int pp = 0; pp < 64; ++pp) { const float cr = cre[pp], cii = cim[pp];
          const f32x4 er = *(const LAS f32x4*)(scr + pp * 16 + ci), ei = *(const LAS f32x4*)(scr + 1024 + pp * 16 + ci);
          acc += cr * er - cii * ei; }
      if (j == 0) { const float dv = FIN(19)[g * 16 + co];
#pragma unroll
          for (int k = 0; k < 4; ++k) if (ci + k == co) acc[k] += dv; }
      u32x2 o; o.x = pk2(acc[0], acc[1]); o.y = pk2(acc[2], acc[3]);
      *(GAS u32x2*)(KT + (size_t)(j + 15) * 256 + co * 16 + ci) = o;
      LDS_WAIT(); asm volatile("" ::: "memory");
    }
    { float ar, ai; ssm_pow(P, j + 1, ar, ai);
#pragma unroll 4
      for (int co = 0; co < 16; ++co) { const float cr = FIN(17)[(size_t)(g * 16 + co) * 64 + p], cii = FIN(18)[(size_t)(g * 16 + co) * 64 + p];
          bf16* row = BH + (size_t)(j * 16 + co) * 128;
          row[p] = (bf16)f2bf(cr * ar - cii * ai); row[64 + p] = (bf16)f2bf(-(cr * ai + cii * ar)); }
    }
    { float ar, ai; ssm_pow(P, 31 - j, ar, ai);
      u32x4 r0, r1, i0, i1; float er[16], ei[16];
#pragma unroll
      for (int c = 0; c < 16; ++c) { er[c] = ar * bbr[c] - ai * bbi[c]; ei[c] = ar * bbi[c] + ai * bbr[c]; }
      r0.x = pk2(er[0], er[1]); r0.y = pk2(er[2], er[3]); r0.z = pk2(er[4], er[5]); r0.w = pk2(er[6], er[7]);
      r1.x = pk2(er[8], er[9]); r1.y = pk2(er[10], er[11]); r1.z = pk2(er[12], er[13]); r1.w = pk2(er[14], er[15]);
      i0.x = pk2(ei[0], ei[1]); i0.y = pk2(ei[2], ei[3]); i0.z = pk2(ei[4], ei[5]); i0.w = pk2(ei[6], ei[7]);
      i1.x = pk2(ei[8], ei[9]); i1.y = pk2(ei[10], ei[11]); i1.z = pk2(ei[12], ei[13]); i1.w = pk2(ei[14], ei[15]);
      GAS u32x4* wr_ = (GAS u32x4*)(W1T + (size_t)p * 512 + j * 16); wr_[0] = r0; wr_[1] = r1;
      GAS u32x4* wi_ = (GAS u32x4*)(W1T + (size_t)(64 + p) * 512 + j * 16); wi_[0] = i0; wi_[1] = i1;
    }
    if (j == 0) {
        for (int q = lane; q < 480; q += 64) ((GAS u32x4*)KT)[q] = (u32x4){0u, 0u, 0u, 0u};
        float* sp = (float*)(F.ws + WS_SSMP);
        float ar, ai; ssm_pow(P, 32, ar, ai);
        sp[SSMP_A32 / 4 + (g * 64 + p) * 2] = ar; sp[SSMP_A32 / 4 + (g * 64 + p) * 2 + 1] = ai;
        ssm_pow(P, 1, ar, ai);
        sp[SSMP_A1 / 4 + (g * 64 + p) * 2] = ar; sp[SSMP_A1 / 4 + (g * 64 + p) * 2 + 1] = ai;
#pragma unroll
        for (int c = 0; c < 16; ++c) { sp[SSMP_BB / 4 + ((size_t)(g * 64 + p) * 16 + c) * 2] = bbr[c]; sp[SSMP_BB / 4 + ((size_t)(g * 64 + p) * 16 + c) * 2 + 1] = bbi[c]; }
    }
}
__device__ __forceinline__ void p0_prologue(Frame& F) {
    LAS float* scr = (LAS float*)(F.lds + F.wave * 16384);
    const int gw = F.bid * NWAVES + F.wave, NGW = F.G * NWAVES;
    constexpr int I_G = (DM / 64) * (FF / 32), I_D = (FF / 64) * (DM / 32), I_IN = (DM / 64) * (NIN / 32), I_SQ = (DM / 64) * (DM / 32), I_PB = (SW / 64) * (DM / 32);
    constexpr int NITEMS = 4 * I_G + 2 * I_D + I_IN + 3 * I_SQ + I_PB;
    for (int it = gw; it < NITEMS; it += NGW) {
        int r = it;
#define TR_ITEM(cnt, W_, K_, N_, WT_, rmap, scale_) if (r < (cnt)) { const int nblk = (N_) / 32, kb = r / nblk, nb = r % nblk; \
            p0_transpose_item(W_, K_, N_, (bf16*)(F.ws + (WT_)), rmap(32 * nb), scr, 64 * kb, 32 * nb, scale_, F.lane); continue; } r -= (cnt);
        TR_ITEM(I_G, FIN(8), DM, FF, WS_WGU1, rmap_gate, FIN(7))
        TR_ITEM(I_G, FIN(9), DM, FF, WS_WGU1, rmap_up, FIN(7))
        TR_ITEM(I_D, FIN(10), FF, DM, WS_WD1, rmap_ident, nullptr)
        TR_ITEM(I_IN, FIN(12), DM, NIN, WS_WIN, rmap_win, FIN(11))
        TR_ITEM(I_SQ, FIN(21), DM, DM, WS_WGLU, rmap_ident, nullptr)
        TR_ITEM(I_SQ, FIN(24), DM, DM, WS_WPA, rmap_ident, nullptr)
        TR_ITEM(I_SQ, FIN(26), DM, DM, WS_WOUT, rmap_ident, nullptr)
        TR_ITEM(I_PB, FIN(25), SW, DM, WS_WPB, rmap_ident, nullptr)
        TR_ITEM(I_G, FIN(28), DM, FF, WS_WGU2, rmap_gate, FIN(27))
        TR_ITEM(I_G, FIN(29), DM, FF, WS_WGU2, rmap_up, FIN(27))
        TR_ITEM(I_D, FIN(30), FF, DM, WS_WD2, rmap_ident, nullptr)
#undef TR_ITEM
    }
    {
        bf16* XB = (bf16*)(F.ws + WS_XBF); float* SS0 = (float*)(F.ws + WS_SS0);
        for (int m0 = 2 * gw; m0 < MPR + NSMP; m0 += 2 * NGW) {
            f32x4 v[2][4];
#pragma unroll
            for (int r = 0; r < 2; ++r) { const int m = m0 + r; const float* xrow = (m < MPR) ? FIN(0) + (size_t)m * DM : FIN(1) + (size_t)(m - MPR) * DM;
                const GAS f32x4* xr = (const GAS f32x4*)xrow + F.lane;
#pragma unroll
                for (int j = 0; j < 4; ++j) v[r][j] = __builtin_nontemporal_load(xr + 64 * j); }
#pragma unroll
            for (int r = 0; r < 2; ++r) { const int m = m0 + r; float s = 0.f;
#pragma unroll
                for (int j = 0; j < 4; ++j) s += (v[r][j].x * v[r][j].x + v[r][j].y * v[r][j].y) + (v[r][j].z * v[r][j].z + v[r][j].w * v[r][j].w);
                s = wave_sum(s);
                GAS u32x2* o8 = (GAS u32x2*)(XB + (size_t)m * DM) + F.lane;
#pragma unroll
                for (int j = 0; j < 4; ++j) { u32x2 o; o.x = pk2(v[r][j].x, v[r][j].y); o.y = pk2(v[r][j].z, v[r][j].w); o8[64 * j] = o; }
                if (F.lane == 0) SS0[m] = s; }
        }
    }
    for (int t = gw; t < NG * 32; t += NGW) p0_ssm_task(F, t >> 5, t & 31, scr);
    if (F.G == 256) bg_copy(F, BGO_P0 + F.bid * BGW_P0, BGO_P0 + (F.bid + 1) * BGW_P0, F.wave, NWAVES);
    else bg_copy(F, (int)((long)BGW_TOT * F.bid / F.G), (int)((long)BGW_TOT * (F.bid + 1) / F.G), F.wave, NWAVES);
}


typedef f32x4 AccT[2][2][4][2];
__device__ __forceinline__ float rsq(float x) { return __builtin_amdgcn_rsqf(x); }
__device__ __forceinline__ float row_rstd16(const float* ssp, int row) {
    const GAS f32x4* p = (const GAS f32x4*)(ssp + (size_t)row * 16);
    const f32x4 a = p[0], b = p[1], c = p[2], d = p[3];
    const float s = ((a.x + a.y) + (a.z + a.w)) + ((b.x + b.y) + (b.z + b.w)) + ((c.x + c.y) + (c.z + c.w)) + ((d.x + d.y) + (d.z + d.w));
    return rsq(s * (1.0f / DM) + RMS_EPS);
}
__device__ __forceinline__ u32x4 pack8(const f32x4& a, const f32x4& b) { u32x4 w; w.x = cvt_pk_bf16(a[0], a[1]); w.y = cvt_pk_bf16(a[2], a[3]); w.z = cvt_pk_bf16(b[0], b[1]); w.w = cvt_pk_bf16(b[2], b[3]); return w; }
__device__ __forceinline__ void unpack8(const u32x4 w, f32x4& a, f32x4& b) { a = (f32x4){bflo(w.x), bfhi(w.x), bflo(w.y), bfhi(w.y)}; b = (f32x4){bflo(w.z), bfhi(w.z), bflo(w.w), bfhi(w.w)}; }

constexpr int RSTAB_OFF = 131584, RSTAB_S_OFF = RSTAB_OFF + 8 * 1024;
static_assert(RSTAB_S_OFF + 128 <= LDS_BYTES && RSTAB_OFF >= MISC_OFF + 128, "LDS map");
template <class Sched> __device__ __forceinline__ void fill_rstd(Frame& F, const Sched& S, const float* ss, int npart) {
    LAS float* tab = (LAS float*)(F.lds + RSTAB_OFF); LAS float* tabs = (LAS float*)(F.lds + RSTAB_S_OFF);
    ge::Seg sg;
    for (int i = 0; i < 8 && S.seg(i, sg); ++i) if (F.tid < 256) { const int row = sg.pm * 256 + F.tid;
        tab[i * 256 + F.tid] = (npart == 1) ? rsq(ss[row] * (1.0f / DM) + RMS_EPS) : row_rstd16(ss, row); }
    if (F.tid < NSMP) { const int row = MPR + F.tid; float r;
        if (npart == 1) r = rsq(ss[row] * (1.0f / DM) + RMS_EPS);
        else { const GAS f32x4* pp = (const GAS f32x4*)((const float*)(F.ws + WS_SSPS) + F.tid * 32); float sm = 0.f;
#pragma unroll
            for (int k = 0; k < 8; ++k) { const f32x4 v = pp[k]; sm += (v.x + v.y) + (v.z + v.w); }
            r = rsq(sm * (1.0f / DM) + RMS_EPS); }
        tabs[F.tid] = r; }
    __syncthreads();
}
struct EpiGateUp {
    const LAS float* rs; bf16* HID;
    template <int AI_N = 2, int M_N = 4> __device__ __forceinline__ void run(const AccT& acc, const ge::Seg& u, int wr, int wc, int fr, int fq) const {
        const int row0 = u.pm * 256 + wr * 64 + fr, col0 = u.pn * 128 + wc * 32 + 8 * fq; const LAS float* rp = rs + u.aux * 256 + wr * 64 + fr;
        float rv[AI_N][M_N];
#pragma unroll
        for (int ai = 0; ai < AI_N; ++ai)
#pragma unroll
            for (int m = 0; m < M_N; ++m) rv[ai][m] = rp[ai * 128 + m * 16];
#pragma unroll
        for (int ai = 0; ai < AI_N; ++ai)
#pragma unroll
            for (int m = 0; m < M_N; ++m) { const int row = row0 + ai * 128 + m * 16; const float rstd = rv[ai][m];
                f32x4 h[2];
#pragma unroll
                for (int n = 0; n < 2; ++n)
#pragma unroll
                    for (int i = 0; i < 4; ++i) { const float g = acc[ai][0][m][n][i] * rstd, up = acc[ai][1][m][n][i] * rstd; h[n][i] = g * sigmoidf_(g) * up; }
                *(GAS u32x4*)(HID + (size_t)row * FF + col0) = pack8(h[0], h[1]); }
    }
};
template <bool FINAL> struct EpiResid {
    float alpha; bf16* xb; float* ssp; float* out; float* ssps;
    template <int AI_N = 2, int M_N = 4> __device__ __forceinline__ void run(const AccT& acc, const ge::Seg& u, int wr, int wc, int fr, int fq) const {
        const int row0 = u.pm * 256 + wr * 64 + fr, col0 = u.pn * 256 + wc * 32 + 8 * fq;
#pragma unroll
        for (int ai = 0; ai < AI_N; ++ai) {
            u32x4 bw[M_N][2];
#pragma unroll
            for (int m = 0; m < M_N; ++m)
#pragma unroll
                for (int bj = 0; bj < 2; ++bj) bw[m][bj] = *(const GAS u32x4*)(xb + (size_t)(row0 + ai * 128 + m * 16) * DM + col0 + bj * 128);
#pragma unroll
            for (int m = 0; m < M_N; ++m) { const int row = row0 + ai * 128 + m * 16; float sq = 0.f;
                const size_t doff = (row < MPR) ? O_YP + (size_t)row * DM : O_YS + (size_t)(row - MPR) * DM;
#pragma unroll
                for (int bj = 0; bj < 2; ++bj) if ((u.bjmask >> bj) & 1) { const size_t off = (size_t)row * DM + col0 + bj * 128;
                    f32x4 b0, b1; unpack8(bw[m][bj], b0, b1);
                    const f32x4 o0 = b0 + alpha * acc[ai][bj][m][0], o1 = b1 + alpha * acc[ai][bj][m][1];
                    if (FINAL) { *(GAS f32x4*)(out + doff + col0 + bj * 128) = o0; *(GAS f32x4*)(out + doff + col0 + bj * 128 + 4) = o1; }
                    else { *(GAS u32x4*)(xb + off) = pack8(o0, o1);
                        sq += (o0[0] * o0[0] + o0[1] * o0[1]) + (o0[2] * o0[2] + o0[3] * o0[3]) + (o1[0] * o1[0] + o1[1] * o1[1]) + (o1[2] * o1[2] + o1[3] * o1[3]); } }
                if (!FINAL) { sq += __shfl_xor(sq, 16); sq += __shfl_xor(sq, 32);
                    if (fq == 0) { if (u.bjmask == 3) ssp[(size_t)row * 16 + u.pn * 4 + wc] = sq; else ssps[(size_t)(row - MPR) * 32 + u.pn * 8 + wc * 2 + (u.bjmask >> 1)] = sq; } } }
        }
    }
};
struct EpiWin {
    const LAS float* rs; bf16 *U, *Q, *K, *V, *GA, *GB; float* US; const float *qg, *kg; float* out;
    __device__ __forceinline__ float* kvdst(int grp, int row, int which) const {
        const int W = 128 << (2 * grp);
        if (row < MPR) { const int b = row >> 12, t = row & 4095; if (t < SEQ - W) return nullptr;
            return out + (grp == 0 ? O_PKV0 : grp == 1 ? O_PKV1 : O_PKV2) + ((size_t)(b * W + t - (SEQ - W)) * 2 + which) * 256; }
        const int sb = row - MPR; return out + (grp == 0 ? O_SKV0 : grp == 1 ? O_SKV1 : O_SKV2) + ((size_t)(sb * W + W - 1) * 2 + which) * 256;
    }
    template <int AI_N = 2, int M_N = 4> __device__ __forceinline__ void run(const AccT& acc, const ge::Seg& u, int wr, int wc, int fr, int fq) const {
        const int row0 = u.pm * 256 + wr * 64 + fr, pn = u.pn, cl0 = 64 * wc + 8 * fq; const LAS float* rp = rs + u.aux * 256 + wr * 64 + fr;
        float rv[AI_N][M_N];
#pragma unroll
        for (int ai = 0; ai < AI_N; ++ai)
#pragma unroll
            for (int m = 0; m < M_N; ++m) rv[ai][m] = rp[ai * 128 + m * 16];
        f32x4 gn[2][2];
        if (pn >= 4 && pn < 10) { const float* gp = (pn < 7) ? qg : kg; const float sc = (pn < 7) ? 0.125f : 1.0f;
#pragma unroll
            for (int bj = 0; bj < 2; ++bj) { gn[bj][0] = *(const GAS f32x4*)(gp + 32 * bj + 8 * fq) * sc; gn[bj][1] = *(const GAS f32x4*)(gp + 32 * bj + 8 * fq + 4) * sc; } }
#pragma unroll
        for (int ai = 0; ai < AI_N; ++ai)
#pragma unroll
            for (int m = 0; m < M_N; ++m) { const int row = row0 + ai * 128 + m * 16;
                const float rstd = rv[ai][m];
                f32x4 v[2][2];
#pragma unroll
                for (int bj = 0; bj < 2; ++bj)
#pragma unroll
                    for (int n = 0; n < 2; ++n) v[bj][n] = acc[ai][bj][m][n] * rstd;
                if (pn < 4) {
#pragma unroll
                    for (int bj = 0; bj < 2; ++bj) { const int c = 256 * pn + cl0 + 32 * bj, g = c >> 4, c0 = c & 15;
                        if (row < MPR) { const int b = row >> 12, t = row & 4095; *(GAS u32x4*)(U + ((size_t)((g * 4 + b) * SEQ + t)) * 16 + c0) = pack8(v[bj][0], v[bj][1]); }
                        else { float* d = US + (size_t)(row - MPR) * DM + c; *(GAS f32x4*)d = v[bj][0]; *(GAS f32x4*)(d + 4) = v[bj][1]; } }
                } else if (pn < 10) {
                    const bool isq = pn < 7; const int grp = isq ? pn - 4 : pn - 7;
                    float sq = 0.f;
#pragma unroll
                    for (int bj = 0; bj < 2; ++bj)
#pragma unroll
                        for (int n = 0; n < 2; ++n) sq += (v[bj][n][0] * v[bj][n][0] + v[bj][n][1] * v[bj][n][1]) + (v[bj][n][2] * v[bj][n][2] + v[bj][n][3] * v[bj][n][3]);
                    sq += __shfl_xor(sq, 16); sq += __shfl_xor(sq, 32);
                    const float r = rsq(sq * (1.0f / HD) + RMS_EPS);
                    float* kd = isq ? nullptr : kvdst(grp, row, 0);
#pragma unroll
                    for (int bj = 0; bj < 2; ++bj) { const int d0 = 32 * bj + 8 * fq;
                        const f32x4 o0 = v[bj][0] * r * gn[bj][0], o1 = v[bj][1] * r * gn[bj][1];
                        *(GAS u32x4*)((isq ? Q : K) + (size_t)row * AW + grp * 256 + wc * 64 + d0) = pack8(o0, o1);
                        if (kd) { *(GAS f32x4*)(kd + wc * 64 + d0) = o0; *(GAS f32x4*)(kd + wc * 64 + d0 + 4) = o1; } }
                } else if (pn < 13) {
                    const int grp = pn - 10; float* vd = kvdst(grp, row, 1);
#pragma unroll
                    for (int bj = 0; bj < 2; ++bj) { const int d0 = 32 * bj + 8 * fq;
                        *(GAS u32x4*)(V + (size_t)row * AW + grp * 256 + wc * 64 + d0) = pack8(v[bj][0], v[bj][1]);
                        if (vd) { *(GAS f32x4*)(vd + wc * 64 + d0) = v[bj][0]; *(GAS f32x4*)(vd + wc * 64 + d0 + 4) = v[bj][1]; } }
                } else {
                    bf16* G = pn < 17 ? GA : GB; const int cb = 256 * (pn < 17 ? pn - 13 : pn - 17);
#pragma unroll
                    for (int bj = 0; bj < 2; ++bj) { f32x4 s0, s1;
#pragma unroll
                        for (int i = 0; i < 4; ++i) { s0[i] = sigmoidf_(v[bj][0][i]); s1[i] = sigmoidf_(v[bj][1][i]); }
                        *(GAS u32x4*)(G + (size_t)row * DM + cb + cl0 + 32 * bj) = pack8(s0, s1); }
                } }
    }
};
struct EpiState {
    float* SST;
    template <int AI_N = 2, int M_N = 4> __device__ __forceinline__ void run(const AccT& acc, const ge::Seg& u, int wr, int wc, int fr, int fq) const {
        const int r0 = u.pm * 256 + wr * 64 + fr;
#pragma unroll
        for (int ai = 0; ai < AI_N; ++ai)
#pragma unroll
            for (int m = 0; m < M_N; ++m) { float* d = SST + ((size_t)u.aux * 512 + r0 + ai * 128 + m * 16) * 128 + wc * 32 + 8 * fq;
                *(GAS f32x4*)d = acc[ai][0][m][0]; *(GAS f32x4*)(d + 4) = acc[ai][0][m][1]; }
    }
};
struct EpiStateLds {
    template <int AI_N = 2, int M_N = 4> __device__ __forceinline__ void run(const AccT&, const ge::Seg&, int, int, int, int) const {}
    __device__ __forceinline__ void drain(const AccT& acc, const ge::Seg&, int wr, int wc, int fr, int fq, LAS unsigned char* lds) const {
#pragma unroll
        for (int ai = 0; ai < 2; ++ai)
#pragma unroll
            for (int m = 0; m < 4; ++m) { const int row = ai * 128 + wr * 64 + m * 16 + fr, sl = (wc * 32 + 8 * fq) ^ (8 * fr);
                LAS float* d = (LAS float*)lds + row * 128 + sl; *(LAS f32x4*)d = acc[ai][0][m][0]; *(LAS f32x4*)(d + 4) = acc[ai][0][m][1]; }
    }
};
struct EpiSsmY {
    bf16* YS;
    template <int AI_N = 2, int M_N = 4> __device__ __forceinline__ void run(const AccT& acc, const ge::Seg& u, int wr, int wc, int fr, int fq) const {
        const int g = u.aux, r0 = u.pm * 256 + wr * 64 + fr;
#pragma unroll
        for (int ai = 0; ai < AI_N; ++ai)
#pragma unroll
            for (int m = 0; m < M_N; ++m) { const int r = r0 + ai * 128 + m * 16, b = r >> 7, chunk = r & 127;
#pragma unroll
                for (int bj = 0; bj < 2; ++bj) { const int slot = 128 * bj + 32 * wc + 8 * fq, tp = 16 * u.pn + (slot >> 4), co0 = slot & 15;
                    f32x4 y0 = acc[ai][bj][m][0], y1 = acc[ai][bj][m][1];
#pragma unroll
                    for (int i = 0; i < 4; ++i) { y0[i] = gelu_tanh(y0[i]); y1[i] = gelu_tanh(y1[i]); }
                    const size_t tok = (size_t)b * SEQ + chunk * CH + tp;
                    *(GAS u32x4*)(YS + tok * DM + g * 16 + co0) = pack8(y0, y1); } }
    }
};
template <int MODE> struct EpiElem {
    const bf16* P; const bf16* Q2; bf16* O;
    template <int AI_N = 2, int M_N = 4> __device__ __forceinline__ void run(const AccT& acc, const ge::Seg& u, int wr, int wc, int fr, int fq) const {
        const int row0 = u.pm * 256 + wr * 64 + fr, col0 = u.pn * 256 + wc * 32 + 8 * fq;
#pragma unroll
        for (int ai = 0; ai < AI_N; ++ai) {
            u32x4 pw[M_N][2], qw[M_N][2];
#pragma unroll
            for (int m = 0; m < M_N; ++m)
#pragma unroll
                for (int bj = 0; bj < 2; ++bj) if ((u.bjmask >> bj) & 1) { const size_t off = (size_t)(row0 + ai * 128 + m * 16) * DM + col0 + bj * 128;
                    pw[m][bj] = *(const GAS u32x4*)(P + off); if (MODE == 2) qw[m][bj] = *(const GAS u32x4*)(Q2 + off); }
#pragma unroll
            for (int m = 0; m < M_N; ++m)
#pragma unroll
                for (int bj = 0; bj < 2; ++bj) if ((u.bjmask >> bj) & 1) { const size_t off = (size_t)(row0 + ai * 128 + m * 16) * DM + col0 + bj * 128;
                    f32x4 p0, p1; unpack8(pw[m][bj], p0, p1);
                    f32x4 o0, o1; const f32x4 a0 = acc[ai][bj][m][0], a1 = acc[ai][bj][m][1];
                    if (MODE == 0) {
#pragma unroll
                        for (int i = 0; i < 4; ++i) { o0[i] = p0[i] * sigmoidf_(a0[i]); o1[i] = p1[i] * sigmoidf_(a1[i]); }
                    } else if (MODE == 1) { o0 = p0 * a0; o1 = p1 * a1; }
                    else { f32x4 q0, q1; unpack8(qw[m][bj], q0, q1); o0 = p0 * a0 + q0; o1 = p1 * a1 + q1; }
                    *(GAS u32x4*)(O + off) = pack8(o0, o1); }
        }
    }
};

template <class Epi>
__device__ __forceinline__ void skinny_unit(LAS unsigned char* lds, const bf16* A, int lda, const bf16* Bt, int ldb, int K, const Epi& E, int pn, int wc, int bjmask) {
    const int tid = threadIdx.x, w = __builtin_amdgcn_readfirstlane(tid >> 6), lane = tid & 63, fr = lane & 15, fq = lane >> 4;
    const int kw = K / 8, k00 = w * kw;
    f32x4 acc[2][2][2];
#pragma unroll
    for (int b = 0; b < 2; ++b)
#pragma unroll
        for (int m = 0; m < 2; ++m)
#pragma unroll
            for (int n = 0; n < 2; ++n) acc[b][m][n] = (f32x4){0.f, 0.f, 0.f, 0.f};
    const bf16* Ar = A + (size_t)(MPR + fr) * lda + k00 + 8 * fq;
    const bf16* Br = Bt + (size_t)(pn * 256 + 32 * wc + 8 * (fr >> 2) + (fr & 3)) * ldb + k00 + 8 * fq;
#pragma unroll 4
    for (int ks = 0; ks < kw; ks += 32) {
        bf16x8 a[2];
#pragma unroll
        for (int m = 0; m < 2; ++m) a[m] = *(const GAS bf16x8*)(Ar + (size_t)(16 * m) * lda + ks);
#pragma unroll
        for (int b = 0; b < 2; ++b) if ((bjmask >> b) & 1) {
#pragma unroll
            for (int n = 0; n < 2; ++n) { const bf16x8 bf = *(const GAS bf16x8*)(Br + (size_t)(128 * b + 4 * n) * ldb + ks);
#pragma unroll
                for (int m = 0; m < 2; ++m) acc[b][m][n] = __builtin_amdgcn_mfma_f32_16x16x32_bf16(bf, a[m], acc[b][m][n], 0, 0, 0); } }
    }
    LAS f32x4* T = (LAS f32x4*)lds;
#define SK_WR(slot) do { _Pragma("unroll") for (int b = 0; b < 2; ++b) _Pragma("unroll") for (int m = 0; m < 2; ++m) _Pragma("unroll") for (int n = 0; n < 2; ++n) T[(slot) * 512 + (((b * 2 + m) * 2 + n) * 64) + lane] = acc[b][m][n]; } while (0)
#define SK_ADD(slot) do { _Pragma("unroll") for (int b = 0; b < 2; ++b) _Pragma("unroll") for (int m = 0; m < 2; ++m) _Pragma("unroll") for (int n = 0; n < 2; ++n) acc[b][m][n] = acc[b][m][n] + T[(slot) * 512 + (((b * 2 + m) * 2 + n) * 64) + lane]; } while (0)
    if (w >= 4) SK_WR(w - 4);
    __syncthreads();
    if (w < 4) SK_ADD(w);
    if (w == 2 || w == 3) SK_WR(4 + (w - 2));
    __syncthreads();
    if (w < 2) SK_ADD(4 + w);
    if (w == 1) SK_WR(6);
    __syncthreads();
    if (w == 0) {
        SK_ADD(6);
        AccT o;
#pragma unroll
        for (int b = 0; b < 2; ++b)
#pragma unroll
            for (int m = 0; m < 2; ++m)
#pragma unroll
                for (int n = 0; n < 2; ++n) o[0][b][m][n] = acc[b][m][n];
        ge::Seg u; u.A = nullptr; u.B = nullptr; u.nt = 0; u.flags = 1; u.geo = 0; u.pm = MPR / 256; u.pn = pn; u.aux = 0; u.bjmask = bjmask;
        E.template run<1, 2>(o, u, 0, wc, fr, fq);
    }
#undef SK_WR
#undef SK_ADD
    __syncthreads();
}
template <bool SPLIT, class Epi>
__device__ __forceinline__ void skinny_phase(Frame& F, const void* A, int lda, const void* Bt, int ldb, int N, int K, const Epi& E) {
    const int nS = SPLIT ? N / 32 : N / 64;
    for (int j = F.G - 1 - F.bid; j < nS; j += F.G) {
        if (SPLIT) skinny_unit(F.lds, (const bf16*)A, lda, (const bf16*)Bt, ldb, K, E, j >> 3, (j >> 1) & 3, 1 << (j & 1));
        else skinny_unit(F.lds, (const bf16*)A, lda, (const bf16*)Bt, ldb, K, E, j >> 2, j & 3, 3); }
}

struct StateSched {
    const char* U; const char* W1T; int G, c;
    __device__ __forceinline__ bool seg(int i, ge::Seg& s) const {
        const int un = i * G + c; if (un >= 128) return false;
        const int g = un >> 1, pm = un & 1;
        s.A = U + ((size_t)g * 512 + 256 * pm) * 1024; s.B = W1T + (size_t)g * 128 * 1024; s.nt = 8; s.flags = 1; s.geo = 0; s.pm = pm; s.pn = 0; s.aux = g; s.bjmask = 3; return true;
    }
};
struct SsmYSched {
    const char* HS; const char* BH; const char* U; const char* KT; int G, c;
    __device__ __forceinline__ bool seg(int i, ge::Seg& s) const {
        const int un = (i >> 1) * G + c; if (un >= 256) return false;
        const int g = un >> 2, pm = (un >> 1) & 1, pn = un & 1;
        s.pm = pm; s.pn = pn; s.aux = g; s.bjmask = 3;
        if ((i & 1) == 0) { s.A = HS + ((size_t)g * 512 + 256 * pm) * 256; s.B = BH + ((size_t)g * 512 + 256 * pn) * 256; s.nt = 2; s.flags = 0; s.geo = 0; }
        else { s.A = U + ((size_t)g * 512 + 256 * pm) * 1024; s.B = KT + (size_t)g * KT_STRIDE + (size_t)(16 * pn) * 512; s.nt = 4 * (pn + 1); s.flags = 1; s.geo = 1; }
        return true;
    }
};

struct SsmYSchedB {
    const char* HS; const char* BH; const char* U; const char* KT; int c;
    __device__ __forceinline__ bool seg(int i, ge::Seg& s) const {
        if (i >= 4) return false;
        const int g = c >> 1, pm = c & 1, pn = i >> 1;
        s.pm = pm; s.pn = pn; s.aux = g; s.bjmask = 3;
        if ((i & 1) == 0) { s.A = HS + ((size_t)g * 512 + 256 * pm) * 256; s.B = BH + ((size_t)g * 512 + 256 * pn) * 256; s.nt = 2; s.flags = 0; s.geo = 0; }
        else { s.A = U + ((size_t)g * 512 + 256 * pm) * 1024; s.B = KT + (size_t)g * KT_STRIDE + (size_t)(16 * pn) * 512; s.nt = 4 * (pn + 1); s.flags = 1; s.geo = 1; }
        return true;
    }
};

constexpr int ATT_RB = 144;
constexpr int ATT_K = 0, ATT_V = 384 * ATT_RB;
constexpr float LOG2E = 1.4426950408889634f, LN2 = 0.6931471805599453f;
__device__ __forceinline__ float alibi_slope(int g, int hc) { return exp2f(-8.0f * (float)(4 * g + hc + 1) / 12.0f); }
__device__ __forceinline__ void attn_item(Frame& F, int it) {
    const int g = it >> 8, rem = it & 255, b = rem >> 6, hc = (rem >> 4) & 3, idx = rem & 15;
    const int dsh = 2 * g, d = 1 << dsh, r = idx & (d - 1), qb = idx >> dsh, i0 = qb * 256;
    const bf16* Qg = (const bf16*)(F.ws + WS_Q) + g * 256 + hc * 64;
    const bf16* Kg = (const bf16*)(F.ws + WS_K) + g * 256 + hc * 64;
    const bf16* Vg = (const bf16*)(F.ws + WS_V) + g * 256 + hc * 64;
    LAS unsigned char* lds = F.lds;
    {
        const int piece = F.tid & 7;
#pragma unroll
        for (int pass = 0; pass < 6; ++pass) { const int rho = pass * 64 + (F.tid >> 3), i = i0 - 128 + rho;
            u32x4 kv = (u32x4){0u, 0u, 0u, 0u}, vv = kv;
            if (i >= 0) { const size_t tok = (size_t)b * SEQ + (size_t)i * d + r; kv = *(const GAS u32x4*)(Kg + tok * AW + piece * 8); vv = *(const GAS u32x4*)(Vg + tok * AW + piece * 8); }
            *(LAS u32x4*)(lds + ATT_K + rho * ATT_RB + piece * 16) = kv; *(LAS u32x4*)(lds + ATT_V + rho * ATT_RB + piece * 16) = vv; }
    }
    __syncthreads();
    const int w = F.wave, lane = F.lane, ql = lane & 31, h = lane >> 5;
    const size_t tokq = (size_t)b * SEQ + (size_t)(i0 + 32 * w + ql) * d + r;
    bf16x8 qf[4];
#pragma unroll
    for (int s = 0; s < 4; ++s) qf[s] = *(const GAS bf16x8*)(Qg + tokq * AW + 16 * s + 8 * h);
    f32x16 st[5];
#pragma unroll
    for (int j = 0; j < 5; ++j) { st[j] = (f32x16){0.f, 0.f, 0.f, 0.f, 0.f, 0.f, 0.f, 0.f, 0.f, 0.f, 0.f, 0.f, 0.f, 0.f, 0.f, 0.f};
#pragma unroll
        for (int s = 0; s < 4; ++s) { const bf16x8 kf = *(const LAS bf16x8*)(lds + ATT_K + (32 * w + 32 * j + ql) * ATT_RB + (16 * s + 8 * h) * 2);
            st[j] = __builtin_amdgcn_mfma_f32_32x32x16_bf16(kf, qf[s], st[j], 0, 0, 0); } }
    const float sl2 = alibi_slope(g, hc) * (float)d * LOG2E;
    float mx = -3.0e38f;
#pragma unroll
    for (int j = 0; j < 5; ++j)
#pragma unroll
        for (int rg = 0; rg < 16; ++rg) { const int kvl = (rg & 3) + 8 * (rg >> 2) + 4 * h, delta = 128 + ql - 32 * j - kvl, ikv = i0 - 128 + 32 * w + 32 * j + kvl;
            const bool ok = (delta >= 0) && (delta <= 128) && (ikv >= 0);
            const float s2 = ok ? (st[j][rg] * LOG2E - sl2 * (float)delta) : -3.0e38f;
            st[j][rg] = s2; mx = fmaxf(mx, s2); }
    mx = fmaxf(mx, __shfl_xor(mx, 32));
    float den = 0.f;
#pragma unroll
    for (int j = 0; j < 5; ++j)
#pragma unroll
        for (int rg = 0; rg < 16; ++rg) { const float p = fast_exp2(st[j][rg] - mx); st[j][rg] = p; den += p; }
    den += __shfl_xor(den, 32);
    const float inv = 1.0f / den;
    if (h == 0) ((float*)(F.ws + WS_LSE))[((size_t)g * MPR + tokq) * 4 + hc] = (mx + __log2f(den)) * LN2;
    const int qq = (lane & 15) >> 2, pp = lane & 3, gsel = (lane >> 4) & 1;
    f32x16 o[2];
#pragma unroll
    for (int db = 0; db < 2; ++db) { o[db] = (f32x16){0.f, 0.f, 0.f, 0.f, 0.f, 0.f, 0.f, 0.f, 0.f, 0.f, 0.f, 0.f, 0.f, 0.f, 0.f, 0.f}; }
#pragma unroll
    for (int j = 0; j < 5; ++j)
#pragma unroll
        for (int sp = 0; sp < 2; ++sp) {
            u32x4 pw; pw.x = cvt_pk_bf16(st[j][8 * sp + 0] * inv, st[j][8 * sp + 1] * inv); pw.y = cvt_pk_bf16(st[j][8 * sp + 2] * inv, st[j][8 * sp + 3] * inv);
            pw.z = cvt_pk_bf16(st[j][8 * sp + 4] * inv, st[j][8 * sp + 5] * inv); pw.w = cvt_pk_bf16(st[j][8 * sp + 6] * inv, st[j][8 * sp + 7] * inv);
            const bf16x8 pa = __builtin_bit_cast(bf16x8, pw);
#pragma unroll
            for (int db = 0; db < 2; ++db) {
                LAS unsigned char* vp = lds + ATT_V + (32 * w + 32 * j + 16 * sp + 4 * h + qq) * ATT_RB + (32 * db + 16 * gsel + 4 * pp) * 2;
                const s16x4 lo = __builtin_bit_cast(s16x4, __builtin_amdgcn_ds_read_tr16_b64_v4i16((LAS s16x4*)vp));
                const s16x4 hi = __builtin_bit_cast(s16x4, __builtin_amdgcn_ds_read_tr16_b64_v4i16((LAS s16x4*)(vp + 8 * ATT_RB)));
                const bf16x8 vb = (bf16x8){lo[0], lo[1], lo[2], lo[3], hi[0], hi[1], hi[2], hi[3]};
                o[db] = __builtin_amdgcn_mfma_f32_32x32x16_bf16(pa, vb, o[db], 0, 0, 0); } }
    const int odd = lane & 1;
    bf16* OG = (bf16*)(F.ws + WS_OG) + (size_t)g * MPR * SW + hc * 64 + ((lane & 31) - odd) + 32 * odd;
#pragma unroll
    for (int rg = 0; rg < 16; ++rg) { const int qrow = (rg & 3) + 8 * (rg >> 2) + 4 * h; const size_t tok = (size_t)b * SEQ + (size_t)(i0 + 32 * w + qrow) * d + r;
        const float p0 = __shfl_xor(o[0][rg], 1), p1 = __shfl_xor(o[1][rg], 1);
        *(GAS unsigned*)(OG + tok * SW) = odd ? cvt_pk_bf16(p1, o[1][rg]) : cvt_pk_bf16(o[0][rg], p0); }
    __syncthreads();
}
constexpr size_t WS_SOG = WS_US + 128 * 1024, WS_SLSE = WS_US + 256 * 1024;
__device__ __forceinline__ void attn_sample_task(Frame& F, int task, int scr) {
    const int g = task % 3, sh = task / 3, sb = sh >> 2, hc = sh & 3, lane = F.lane;
    LAS float* ps = (LAS float*)(F.lds + scr);
    const int W = 128 << (2 * g), d = 1 << (2 * g);
    const float* cache = FIN(4 + g) + (size_t)sb * W * 512;
    const float* newkv = F.out + (g == 0 ? O_SKV0 : g == 1 ? O_SKV1 : O_SKV2) + ((size_t)(sb * W + W - 1) * 2) * 256;
    const bf16* Qs = (const bf16*)(F.ws + WS_Q) + (size_t)(MPR + sb) * AW + g * 256 + hc * 64;
    const float slope = alibi_slope(g, hc);
    float s0, s1, s2;
    {   u32x4 qw[8]; f32x4 k0[16], k1[16];
        const float* kr0 = (lane == 0) ? newkv + hc * 64 : cache + (size_t)(W - lane * d) * 512 + hc * 64;
        const float* kr1 = cache + (size_t)(W - (lane + 64) * d) * 512 + hc * 64;
#pragma unroll
        for (int c = 0; c < 8; ++c) qw[c] = *(const GAS u32x4*)(Qs + 8 * c);
#pragma unroll
        for (int c = 0; c < 16; ++c) { k0[c] = *(const GAS f32x4*)(kr0 + 4 * c); k1[c] = *(const GAS f32x4*)(kr1 + 4 * c); }
        float d0 = 0.f, d1 = 0.f;
#pragma unroll
        for (int c = 0; c < 16; ++c) { const unsigned w0 = qw[c >> 1][(c & 1) * 2], w1 = qw[c >> 1][(c & 1) * 2 + 1];
            const float q0 = bflo(w0), q1 = bfhi(w0), q2 = bflo(w1), q3 = bfhi(w1);
            d0 += (k0[c][0] * q0 + k0[c][1] * q1) + (k0[c][2] * q2 + k0[c][3] * q3);
            d1 += (k1[c][0] * q0 + k1[c][1] * q1) + (k1[c][2] * q2 + k1[c][3] * q3); }
        s0 = d0 - slope * (float)(lane * d); s1 = d1 - slope * (float)((lane + 64) * d);
        const float* kr2 = cache + hc * 64;
        const int kg = lane >> 4, dc = lane & 15;
        f32x4 va[16];
#pragma unroll
        for (int c = 0; c < 16; ++c) k0[c] = *(const GAS f32x4*)(kr2 + 4 * c);
#pragma unroll
        for (int k = 0; k < 16; ++k) { const int j = 4 * k + kg; const float* vr = (j == 0) ? newkv + 256 + hc * 64 : cache + (size_t)(W - j * d) * 512 + 256 + hc * 64; va[k] = *(const GAS f32x4*)(vr + 4 * dc); }
        float d2 = 0.f;
#pragma unroll
        for (int c = 0; c < 16; ++c) { const unsigned w0 = qw[c >> 1][(c & 1) * 2], w1 = qw[c >> 1][(c & 1) * 2 + 1];
            d2 += (k0[c][0] * bflo(w0) + k0[c][1] * bfhi(w0)) + (k0[c][2] * bflo(w1) + k0[c][3] * bfhi(w1)); }
        s2 = (lane == 0) ? d2 - slope * (float)(128 * d) : -3.0e38f;
        const float m = wave_max(fmaxf(fmaxf(s0, s1), s2));
        const float p0 = __expf(s0 - m), p1 = __expf(s1 - m), p2 = __expf(s2 - m);
        const float den = wave_sum(p0 + p1 + p2);
        ps[lane] = p0; ps[64 + lane] = p1; ps[128 + lane] = p2;
        LDS_WAIT(); asm volatile("" ::: "memory");
        f32x4 vb[17];
#pragma unroll
        for (int k = 0; k < 17; ++k) { const int j = 4 * (16 + k) + kg; const int jj = j <= 128 ? j : 128; vb[k] = *(const GAS f32x4*)(cache + (size_t)(W - jj * d) * 512 + 256 + hc * 64 + 4 * dc); }
        f32x4 o = (f32x4){0.f, 0.f, 0.f, 0.f};
#pragma unroll
        for (int k = 0; k < 16; ++k) o += ps[4 * k + kg] * va[k];
#pragma unroll
        for (int k = 0; k < 17; ++k) { const int j = 4 * (16 + k) + kg; o += (j <= 128 ? ps[j] : 0.f) * vb[k]; }
#pragma unroll
        for (int c = 0; c < 4; ++c) { o[c] += __shfl_xor(o[c], 16); o[c] += __shfl_xor(o[c], 32); }
        LDS_WAIT(); asm volatile("" ::: "memory");
        if (lane < 16) *(GAS f32x4*)((float*)(F.ws + WS_SOG) + (size_t)(sh * 3 + g) * 64 + 4 * dc) = o * (1.0f / den);
        if (lane == 0) ((float*)(F.ws + WS_SLSE))[sh * 3 + g] = m + __logf(den);
    }
}
__device__ __forceinline__ void sample_mix(Frame& F) {
    const int gt = F.bid * (NWAVES * 64) + F.tid;
    if (gt < NSMP * 4 * 64) { const int sh = gt >> 6, dim = gt & 63, sb = sh >> 2, hc = sh & 3;
        const float lv = ((const float*)(F.ws + WS_SLSE))[sh * 3 + (F.lane % 3)];
        const float l0 = __shfl(lv, 0), l1 = __shfl(lv, 1), l2 = __shfl(lv, 2);
        const float mx = fmaxf(fmaxf(l0, l1), l2); const float w0 = __expf(l0 - mx), w1 = __expf(l1 - mx), w2 = __expf(l2 - mx);
        const float* og = (const float*)(F.ws + WS_SOG) + (size_t)sh * 3 * 64 + dim;
        const float ob = (w0 * og[0] + w1 * og[64] + w2 * og[128]) / (w0 + w1 + w2);
        ((bf16*)(F.ws + WS_OB))[(size_t)(MPR + sb) * SW + hc * 64 + dim] = (bf16)f2bf(ob); }
}

__device__ __forceinline__ void p5_combine(Frame& F) {
    const size_t gt = (size_t)F.bid * (NWAVES * 64) + F.tid, NT = (size_t)F.G * NWAVES * 64;
    const float* LSE = (const float*)(F.ws + WS_LSE); const GAS u32x2* OG = (const GAS u32x2*)(F.ws + WS_OG); bf16* OB = (bf16*)(F.ws + WS_OB);
    for (size_t e = gt; e < (size_t)MPR * 64; e += NT) { const size_t tok = e >> 6; const int hc = (int)(e >> 4) & 3;
        const float l0 = LSE[tok * 4 + hc], l1 = LSE[((size_t)MPR + tok) * 4 + hc], l2 = LSE[((size_t)2 * MPR + tok) * 4 + hc];
        const float mx = fmaxf(fmaxf(l0, l1), l2); const float w0 = __expf(l0 - mx), w1 = __expf(l1 - mx), w2 = __expf(l2 - mx); const float inv = 1.0f / (w0 + w1 + w2);
        const u32x2 aw = OG[e], bw = OG[(size_t)MPR * 64 + e], cw = OG[(size_t)2 * MPR * 64 + e];
        const f32x4 a = (f32x4){bflo(aw.x), bfhi(aw.x), bflo(aw.y), bfhi(aw.y)}, b = (f32x4){bflo(bw.x), bfhi(bw.x), bflo(bw.y), bfhi(bw.y)}, c = (f32x4){bflo(cw.x), bfhi(cw.x), bflo(cw.y), bfhi(cw.y)};
        const f32x4 o = (w0 * a + w1 * b + w2 * c) * inv;
        u32x2 pk; pk.x = cvt_pk_bf16(o[0], o[1]); pk.y = cvt_pk_bf16(o[2], o[3]);
        *(GAS u32x2*)(OB + e * 4) = pk; }
}
__device__ __forceinline__ void p5_carry(Frame& F, int g, int b) {
    const int p = F.lane;
    const float* sp = (const float*)(F.ws + WS_SSMP);
    const float ar = sp[SSMP_A32 / 4 + (g * 64 + p) * 2], ai = sp[SSMP_A32 / 4 + (g * 64 + p) * 2 + 1];
    const float* SST = (const float*)(F.ws + WS_SST) + ((size_t)g * 512 + b * 128) * 128; bf16* HS = (bf16*)(F.ws + WS_HS) + ((size_t)g * 512 + b * 128) * 128;
    float hr = 0.f, hi = 0.f;
    for (int cb = 0; cb < NCH; cb += 16) { float sr[16], si[16];
#pragma unroll
        for (int k = 0; k < 16; ++k) { sr[k] = SST[(size_t)(cb + k) * 128 + p]; si[k] = SST[(size_t)(cb + k) * 128 + 64 + p]; }
#pragma unroll
        for (int k = 0; k < 16; ++k) { HS[(size_t)(cb + k) * 128 + p] = (bf16)f2bf(hr); HS[(size_t)(cb + k) * 128 + 64 + p] = (bf16)f2bf(hi);
            const float nr = ar * hr - ai * hi + sr[k], ni = ar * hi + ai * hr + si[k]; hr = nr; hi = ni; } }
    F.out[O_PSR + (size_t)(b * 64 + g) * 64 + p] = hr; F.out[O_PSI + (size_t)(b * 64 + g) * 64 + p] = hi;
}
__device__ __forceinline__ void p5_carry_lds(Frame& F, int g, int b, int bl) {
    const int p = F.lane;
    const float* sp = (const float*)(F.ws + WS_SSMP);
    const float ar = sp[SSMP_A32 / 4 + (g * 64 + p) * 2], ai = sp[SSMP_A32 / 4 + (g * 64 + p) * 2 + 1];
    const LAS float* SL = (const LAS float*)F.lds + (size_t)bl * 128 * 128; bf16* HS = (bf16*)(F.ws + WS_HS) + ((size_t)g * 512 + b * 128) * 128;
    float hr = 0.f, hi = 0.f;
    for (int cb = 0; cb < NCH; cb += 16) { float sr[16], si[16];
#pragma unroll
        for (int k = 0; k < 16; ++k) { sr[k] = SL[(cb + k) * 128 + (p ^ (8 * k))]; si[k] = SL[(cb + k) * 128 + ((64 + p) ^ (8 * k))]; }
#pragma unroll
        for (int k = 0; k < 16; ++k) { HS[(size_t)(cb + k) * 128 + p] = (bf16)f2bf(hr); HS[(size_t)(cb + k) * 128 + 64 + p] = (bf16)f2bf(hi);
            const float nr = ar * hr - ai * hi + sr[k], ni = ar * hi + ai * hr + si[k]; hr = nr; hi = ni; } }
    F.out[O_PSR + (size_t)(b * 64 + g) * 64 + p] = hr; F.out[O_PSI + (size_t)(b * 64 + g) * 64 + p] = hi;
}
__device__ __forceinline__ void p5_sample_ssm(Frame& F, int sb, int g) {
    const int p = F.lane;
    const float* sp = (const float*)(F.ws + WS_SSMP);
    const float ar = sp[SSMP_A1 / 4 + (g * 64 + p) * 2], ai = sp[SSMP_A1 / 4 + (g * 64 + p) * 2 + 1];
    const float h0r = FIN(2)[(size_t)(sb * 64 + g) * 64 + p], h0i = FIN(3)[(size_t)(sb * 64 + g) * 64 + p];
    const float uval = ((const float*)(F.ws + WS_US))[(size_t)sb * DM + g * 16 + (p & 15)];
    const float dsk = FIN(19)[g * 16 + (p & 15)];
    f32x4 bbv[8]; float cr[16], ci[16];
#pragma unroll
    for (int c = 0; c < 8; ++c) bbv[c] = *(const GAS f32x4*)(sp + SSMP_BB / 4 + (size_t)(g * 64 + p) * 32 + 4 * c);
#pragma unroll
    for (int co = 0; co < 16; ++co) { cr[co] = FIN(17)[(size_t)(g * 16 + co) * 64 + p]; ci[co] = FIN(18)[(size_t)(g * 16 + co) * 64 + p]; }
    float bur = 0.f, bui = 0.f;
#pragma unroll
    for (int c = 0; c < 16; ++c) { const float uc = __shfl(uval, c); bur += bbv[c >> 1][(c & 1) * 2] * uc; bui += bbv[c >> 1][(c & 1) * 2 + 1] * uc; }
    const float hr = ar * h0r - ai * h0i + bur, hi = ar * h0i + ai * h0r + bui;
    F.out[O_SSR + (size_t)(sb * 64 + g) * 64 + p] = hr; F.out[O_SSI + (size_t)(sb * 64 + g) * 64 + p] = hi;
    float yv = 0.f;
#pragma unroll
    for (int co = 0; co < 16; ++co) { const float t = wave_sum(cr[co] * hr - ci[co] * hi); if (p == co) yv = t; }
    if (p < 16) { const float y = yv + dsk * uval; ((bf16*)(F.ws + WS_YSM))[(size_t)(MPR + sb) * DM + g * 16 + p] = (bf16)f2bf(gelu_tanh(y)); }
}

struct Sched2 { ge::StdSched a, b; int na;
    __device__ __forceinline__ bool seg(int i, ge::Seg& s) const { if (i < na) return a.seg(i, s); if (!b.seg(i - na, s)) return false; s.geo = 1; return true; } };
template <class EA, class EB> struct Epi2 { EA e0; EB e1;
    template <int AI_N = 2, int M_N = 4> __device__ __forceinline__ void run(const AccT& acc, const ge::Seg& u, int wr, int wc, int fr, int fq) const {
        if (u.geo == 0) e0.template run<AI_N, M_N>(acc, u, wr, wc, fr, fq); else e1.template run<AI_N, M_N>(acc, u, wr, wc, fr, fq); } };

constexpr int N_PHASES = 12;
__global__ void __launch_bounds__(NWAVES * 64, 2) fwd_kernel(Args args) {
    extern __shared__ __attribute__((aligned(16))) unsigned char lds_raw[];
    Frame F;
    F.lds = (LAS unsigned char*)lds_raw;
    F.tid = threadIdx.x; F.lane = F.tid & 63; F.wave = __builtin_amdgcn_readfirstlane(F.tid >> 6);
    F.G = gridDim.x; F.bid = blockIdx.x;
    F.a = &args; F.out = args.out; F.ws = args.ws;
    volatile LAS unsigned* MISC = (volatile LAS unsigned*)(F.lds + MISC_OFF);
    for (int u = F.tid; u < (LDS_BYTES - LDSCTL_OFF) / 4; u += NWAVES * 64) ((LAS unsigned*)(F.lds + LDSCTL_OFF))[u] = 0u;
    __syncthreads();
    const int lo = args.ph_lo, hi = args.ph_hi;
    const bool use_bar = (hi - lo) > 1;
    XcdBarrier bar; bar.bar = (unsigned*)(F.ws + WS_CTL) + CW_BAR; bar.x = 0; bar.st = nullptr;
    if (use_bar) bar = xcd_barrier_post((unsigned*)(F.ws + WS_CTL) + CW_BAR, MISC + 8);
#ifdef ONLY_PHASE
#define IN(k) ((k) == ONLY_PHASE)
#else
#define IN(k) (lo <= (k) && (k) < hi)
#endif
#define SEAM(k) do { if (IN(k) && IN((k) + 1)) xcd_barrier(bar); } while (0)
    bf16* XBF = (bf16*)(F.ws + WS_XBF); float* SSP = (float*)(F.ws + WS_SSP); bf16* HID = (bf16*)(F.ws + WS_HID);

    if (IN(0)) { p0_prologue(F); } SEAM(0);
    if (IN(1)) {
        ge::StdSched S; S.init(XBF, DM * 2, F.ws + WS_WGU1, DM * 2, MPR, 2 * FF, DM, F.G, F.bid);
        fill_rstd(F, S, (const float*)(F.ws + WS_SS0), 1);
        EpiGateUp E{(const LAS float*)(F.lds + RSTAB_OFF), HID}, Es{(const LAS float*)(F.lds + RSTAB_S_OFF), HID}; const ge::GeoDesc gd[1] = {{DM * 2, DM * 2, 0}};
        skinny_phase<false>(F, XBF, DM, F.ws + WS_WGU1, DM, 2 * FF, DM, Es);
        ge::gemm_phase<EpiGateUp, ge::StdSched, 1>(F.lds, S, E, gd);
        if (F.G == 256 && F.bid >= 128) bg_copy(F, BGO_P1 + (F.bid - 128) * BGW_T, BGO_P1 + (F.bid - 127) * BGW_T, F.wave, NWAVES);
    } SEAM(1);
    if (IN(2)) {
        ge::StdSched S; S.init(HID, FF * 2, F.ws + WS_WD1, FF * 2, MPR, DM, FF, F.G, F.bid);
        EpiResid<false> E{0.5f, XBF, SSP, nullptr, (float*)(F.ws + WS_SSPS)}; const ge::GeoDesc gd[1] = {{FF * 2, FF * 2, 0}};
        skinny_phase<true>(F, HID, FF, F.ws + WS_WD1, FF, DM, FF, E);
        if (F.G == 256 && F.bid < BG_NF) bg_copy(F, BGO_S2 + F.bid * BGW_S2, BGO_S2 + (F.bid + 1) * BGW_S2, F.wave, NWAVES);
        ge::gemm_phase<EpiResid<false>, ge::StdSched, 1>(F.lds, S, E, gd);
    } SEAM(2);
    if (IN(3)) {
        ge::StdSched S; S.init(XBF, DM * 2, F.ws + WS_WIN, DM * 2, MPR, NIN, DM, F.G, F.bid);
        fill_rstd(F, S, SSP, 16);
        EpiWin E{(const LAS float*)(F.lds + RSTAB_OFF), (bf16*)(F.ws + WS_U), (bf16*)(F.ws + WS_Q), (bf16*)(F.ws + WS_K), (bf16*)(F.ws + WS_V), (bf16*)(F.ws + WS_GA), (bf16*)(F.ws + WS_GB),
                 (float*)(F.ws + WS_US), FIN(22), FIN(23), F.out};
        EpiWin Es = E; Es.rs = (const LAS float*)(F.lds + RSTAB_S_OFF);
        const ge::GeoDesc gd[1] = {{DM * 2, DM * 2, 0}};
        skinny_phase<false>(F, XBF, DM, F.ws + WS_WIN, DM, NIN, DM, Es);
        ge::gemm_phase<EpiWin, ge::StdSched, 1>(F.lds, S, E, gd);
        if (F.G == 256 && F.bid >= 64) bg_copy(F, BGO_P3 + (F.bid - 64) * BGW_T, BGO_P3 + (F.bid - 63) * BGW_T, F.wave, NWAVES);
    } SEAM(3);
    const bool px = (F.G == 256) && IN(4) && IN(5) && IN(6);
    if (px) {
        if (F.bid < 128) {
            const int g = F.bid >> 1, pm = F.bid & 1;
            { StateSched S{(const char*)(F.ws + WS_U), (const char*)(F.ws + WS_W1T), F.G, F.bid}; EpiStateLds E{};
              const ge::GeoDesc gd[1] = {{1024, 1024, 0, 1}};
              ge::gemm_phase<EpiStateLds, StateSched, 1, true>(F.lds, S, E, gd); }
            __syncthreads();
            if (F.wave < 2) p5_carry_lds(F, g, 2 * pm + F.wave, F.wave);
            else if (F.wave < 5) attn_sample_task(F, F.bid * 3 + (F.wave - 2), RSTAB_OFF + (F.wave - 2) * 1024);
            else bg_copy(F, BGO_XS + F.bid * BGW_XS, BGO_XS + (F.bid + 1) * BGW_XS, F.wave - 5, 3);
            VM_WAIT(); __syncthreads();
            { SsmYSchedB S{(const char*)(F.ws + WS_HS), (const char*)(F.ws + WS_BH), (const char*)(F.ws + WS_U), (const char*)(F.ws + WS_KT), F.bid};
              EpiSsmY E{(bf16*)(F.ws + WS_YSM)};
              const ge::GeoDesc gd[2] = {{256, 256, 0}, {1024, 0, 1}};
              ge::gemm_phase<EpiSsmY, SsmYSchedB, 2>(F.lds, S, E, gd); }
        } else {
            for (int it = F.bid - 128; it < 768; it += 128) attn_item(F, it);
            for (int t = (F.bid - 128) * NWAVES + F.wave; t < NSMP * NG; t += 128 * NWAVES) p5_sample_ssm(F, t >> 6, t & 63);
            bg_copy(F, BGO_XA + (F.bid - 128) * BGW_XA, BGO_XA + (F.bid - 127) * BGW_XA, F.wave, NWAVES);
        }
    } else {
    if (IN(4)) {
        { StateSched S{(const char*)(F.ws + WS_U), (const char*)(F.ws + WS_W1T), F.G, F.bid}; EpiState E{(float*)(F.ws + WS_SST)};
          const ge::GeoDesc gd[1] = {{1024, 1024, 0}};
          ge::gemm_phase<EpiState, StateSched, 1>(F.lds, S, E, gd); }
        __syncthreads();
        for (int it = F.bid; it < 768; it += F.G) attn_item(F, it);
    } SEAM(4);
    if (IN(5)) {
        for (int t = F.bid * NWAVES + F.wave; t < NSMP * NG; t += F.G * NWAVES) p5_sample_ssm(F, t >> 6, t & 63);
        if (F.wave == 0) for (int u = F.bid; u < 256; u += F.G) p5_carry(F, u >> 2, u & 3);
        if (F.wave == 1 || F.wave == 2) for (int t = (F.wave - 1) * F.G + F.bid; t < NSMP * 4 * 3; t += 2 * F.G) attn_sample_task(F, t, F.wave * 2048);
        if (F.G == 256 && F.wave >= 3) { if (F.bid < 128) bg_copy(F, BGO_XS + F.bid * BGW_XS, BGO_XS + (F.bid + 1) * BGW_XS, F.wave - 3, NWAVES - 3);
                                         else bg_copy(F, BGO_XA + (F.bid - 128) * BGW_XA, BGO_XA + (F.bid - 127) * BGW_XA, F.wave - 3, NWAVES - 3); }
    } SEAM(5);
    if (IN(6)) {
        SsmYSched S{(const char*)(F.ws + WS_HS), (const char*)(F.ws + WS_BH), (const char*)(F.ws + WS_U), (const char*)(F.ws + WS_KT), F.G, F.bid};
        EpiSsmY E{(bf16*)(F.ws + WS_YSM)};
        const ge::GeoDesc gd[2] = {{256, 256, 0}, {1024, 0, 1}};
        ge::gemm_phase<EpiSsmY, SsmYSched, 2>(F.lds, S, E, gd);
    }
    }
    SEAM(6);
    if (IN(7)) {
        p5_combine(F); sample_mix(F);
        ge::StdSched S; S.init(F.ws + WS_YSM, DM * 2, F.ws + WS_WGLU, DM * 2, MPR, DM, DM, F.G, F.bid);
        EpiElem<0> E{(const bf16*)(F.ws + WS_YSM), nullptr, (bf16*)(F.ws + WS_YA)}; const ge::GeoDesc gd[1] = {{DM * 2, DM * 2, 0}};
        skinny_phase<true>(F, F.ws + WS_YSM, DM, F.ws + WS_WGLU, DM, DM, DM, E);
        if (F.G == 256 && F.bid < BG_NF) bg_copy(F, BGO_S7 + F.bid * BGW_S7, BGO_S7 + (F.bid + 1) * BGW_S7, F.wave, NWAVES);
        ge::gemm_phase<EpiElem<0>, ge::StdSched, 1>(F.lds, S, E, gd);
    } SEAM(7);
    if (IN(8)) {
        ge::StdSched S0; S0.init(F.ws + WS_OB, SW * 2, F.ws + WS_WPB, SW * 2, MPR, DM, SW, F.G, F.bid);
        ge::StdSched S1; S1.init(F.ws + WS_YA, DM * 2, F.ws + WS_WPA, DM * 2, MPR, DM, DM, F.G, F.bid);
        EpiElem<1> E0{(const bf16*)(F.ws + WS_GB), nullptr, (bf16*)(F.ws + WS_TB)};
        EpiElem<2> E1{(const bf16*)(F.ws + WS_GA), (const bf16*)(F.ws + WS_TB), (bf16*)(F.ws + WS_YSM)};
        skinny_phase<true>(F, F.ws + WS_OB, SW, F.ws + WS_WPB, SW, DM, SW, E0);
        skinny_phase<true>(F, F.ws + WS_YA, DM, F.ws + WS_WPA, DM, DM, DM, E1);
        if (F.G == 256 && F.bid < BG_NF) bg_copy(F, BGO_S8 + F.bid * BGW_S8, BGO_S8 + (F.bid + 1) * BGW_S8, F.wave, NWAVES);
        int na = 0; { ge::Seg t; while (S0.seg(na, t)) ++na; }
        Sched2 S{S0, S1, na}; Epi2<EpiElem<1>, EpiElem<2> > E{E0, E1};
        const ge::GeoDesc gd[2] = {{SW * 2, SW * 2, 0}, {DM * 2, DM * 2, 0}};
        ge::gemm_phase<Epi2<EpiElem<1>, EpiElem<2> >, Sched2, 2>(F.lds, S, E, gd);
    } SEAM(8);
    if (IN(9)) {
        ge::StdSched S; S.init(F.ws + WS_YSM, DM * 2, F.ws + WS_WOUT, DM * 2, MPR, DM, DM, F.G, F.bid);
        EpiResid<false> E{1.0f, XBF, SSP, nullptr, (float*)(F.ws + WS_SSPS)}; const ge::GeoDesc gd[1] = {{DM * 2, DM * 2, 0}};
        skinny_phase<true>(F, F.ws + WS_YSM, DM, F.ws + WS_WOUT, DM, DM, DM, E);
        if (F.G == 256 && F.bid < BG_NF) bg_copy(F, BGO_S9 + F.bid * BGW_S9, BGO_S9 + (F.bid + 1) * BGW_S9, F.wave, NWAVES);
        ge::gemm_phase<EpiResid<false>, ge::StdSched, 1>(F.lds, S, E, gd);
    } SEAM(9);
    if (IN(10)) {
        ge::StdSched S; S.init(XBF, DM * 2, F.ws + WS_WGU2, DM * 2, MPR, 2 * FF, DM, F.G, F.bid);
        fill_rstd(F, S, SSP, 16);
        EpiGateUp E{(const LAS float*)(F.lds + RSTAB_OFF), HID}, Es{(const LAS float*)(F.lds + RSTAB_S_OFF), HID}; const ge::GeoDesc gd[1] = {{DM * 2, DM * 2, 0}};
        skinny_phase<false>(F, XBF, DM, F.ws + WS_WGU2, DM, 2 * FF, DM, Es);
        ge::gemm_phase<EpiGateUp, ge::StdSched, 1>(F.lds, S, E, gd);
        if (F.G == 256 && F.bid >= 128) bg_copy(F, BGO_P10 + (F.bid - 128) * BGW_T, BGO_P10 + (F.bid - 127) * BGW_T, F.wave, NWAVES);
    } SEAM(10);
    if (IN(11)) {
        ge::StdSched S; S.init(HID, FF * 2, F.ws + WS_WD2, FF * 2, MPR, DM, FF, F.G, F.bid);
        EpiResid<true> E{0.5f, XBF, nullptr, F.out, nullptr}; const ge::GeoDesc gd[1] = {{FF * 2, FF * 2, 0}};
        skinny_phase<true>(F, HID, FF, F.ws + WS_WD2, FF, DM, FF, E);
        if (F.G == 256 && F.bid < BG_NF) bg_copy(F, BGO_S11 + F.bid * BGW_S11, BGO_S11 + (F.bid + 1) * BGW_S11, F.wave, NWAVES);
        ge::gemm_phase<EpiResid<true>, ge::StdSched, 1>(F.lds, S, E, gd);
    }
#undef IN
#undef SEAM
}

#ifndef DBG_LAST_PHASE
#define DBG_LAST_PHASE 11
#endif
#ifndef MK_N_LAUNCHES
#define MK_N_LAUNCHES 1
#endif
extern "C" void kernel_launch(void* const* d_in, const int* in_sizes, int n_in, void* d_out, int out_size, void* d_ws, size_t ws_size, hipStream_t stream) {
    static int grid = 0;
    if (grid == 0) {
        if (n_in != 31 || (size_t)out_size != O_END || ws_size < WS_END) { fprintf(stderr, "kernel_launch: unexpected sizes: n_in %d out %d (want %zu) ws %zu (want >= %zu)\n", n_in, out_size, (size_t)O_END, ws_size, (size_t)WS_END); grid = -1; return; }
        int dev = 0, cus = 0, per_cu = 0;
        if (hipGetDevice(&dev) != hipSuccess || hipDeviceGetAttribute(&cus, hipDeviceAttributeMultiprocessorCount, dev) != hipSuccess) { grid = -1; return; }
        if (hipFuncSetAttribute((const void*)fwd_kernel, hipFuncAttributeMaxDynamicSharedMemorySize, LDS_BYTES) != hipSuccess) { fprintf(stderr, "kernel_launch: hipFuncSetAttribute failed\n"); grid = -1; return; }
        if (hipOccupancyMaxActiveBlocksPerMultiprocessor(&per_cu, (const void*)fwd_kernel, NWAVES * 64, LDS_BYTES) != hipSuccess || per_cu < 1) { fprintf(stderr, "kernel_launch: occupancy query says %d\n", per_cu); per_cu = 1; }
        (void)hipGetLastError();
        grid = cus;
    }
    if (grid < 0) return;
    (void)hipMemsetAsync((char*)d_ws + WS_CTL, 0, CTL_ZERO_BYTES, stream);
    Args a{};
    for (int i = 0; i < 31; ++i) a.in[i] = (const float*)d_in[i];
    a.out = (float*)d_out; a.ws = (unsigned char*)d_ws;
    if (MK_N_LAUNCHES == 1) { a.ph_lo = 0; a.ph_hi = N_PHASES; hipLaunchKernelGGL(fwd_kernel, dim3(grid), dim3(NWAVES * 64), LDS_BYTES, stream, a); }
    else for (int p = 0; p < DBG_LAST_PHASE + 1; ++p) { a.ph_lo = p; a.ph_hi = p + 1; hipLaunchKernelGGL(fwd_kernel, dim3(grid), dim3(NWAVES * 64), LDS_BYTES, stream, a); }
}
```

```cpp
#include <hip/hip_runtime.h>
#include <cstdio>
#include <cstdint>

#define LAS __attribute__((address_space(3)))
#define GAS __attribute__((address_space(1)))
typedef unsigned short bf16;
typedef short bf16x8 __attribute__((ext_vector_type(8)));
typedef short s16x4 __attribute__((ext_vector_type(4)));
typedef float f32x2 __attribute__((ext_vector_type(2)));
typedef float f32x4 __attribute__((ext_vector_type(4)));
typedef float f32x16 __attribute__((ext_vector_type(16)));
typedef unsigned u32x2 __attribute__((ext_vector_type(2)));
typedef unsigned u32x4 __attribute__((ext_vector_type(4)));

constexpr int DM = 1024, NBATCH = 4, SEQ = 4096, MPR = NBATCH * SEQ, NSMP = 32, MP = MPR + 256, FF = 2816, NIN = 5376;
constexpr int NG = 64, GC = 16, NPS = 64, CH = 32, NCH = SEQ / CH;
constexpr int HD = 64, AW = 768, SW = 256;
constexpr float RMS_EPS = 1e-6f;
constexpr int NWAVES = 8;

constexpr size_t O_YP = 0, O_YS = O_YP + (size_t)MPR * DM, O_PSR = O_YS + (size_t)NSMP * DM, O_PSI = O_PSR + 4 * 64 * 64,
                 O_PKV0 = O_PSI + 4 * 64 * 64, O_PKV1 = O_PKV0 + (size_t)4 * 128 * 512, O_PKV2 = O_PKV1 + (size_t)4 * 512 * 512,
                 O_SSR = O_PKV2 + (size_t)4 * 2048 * 512, O_SSI = O_SSR + 32 * 64 * 64, O_SKV0 = O_SSI + 32 * 64 * 64,
                 O_SKV1 = O_SKV0 + (size_t)32 * 128 * 512, O_SKV2 = O_SKV1 + (size_t)32 * 512 * 512, O_END = O_SKV2 + (size_t)32 * 2048 * 512;

constexpr size_t MiB = 1u << 20;
constexpr size_t WS_CTL = 0, CTL_ZERO_BYTES = 128 * 1024;
constexpr size_t WS_WGU1 = 1 * MiB;
constexpr size_t WS_WD1  = 12 * MiB;
constexpr size_t WS_WIN  = 18 * MiB;
constexpr size_t WS_WGLU = 29 * MiB, WS_WPA = 31 * MiB, WS_WOUT = 33 * MiB;
constexpr size_t WS_WPB  = 35 * MiB;
constexpr size_t WS_WGU2 = 36 * MiB, WS_WD2 = 47 * MiB;
constexpr size_t WS_KT   = 53 * MiB;
constexpr size_t KT_STRIDE = 47 * 512;
constexpr size_t WS_BH   = 55 * MiB;
constexpr size_t WS_W1T  = 63 * MiB;
constexpr size_t WS_SSMP = 72 * MiB;
constexpr size_t SSMP_A32 = 0, SSMP_A1 = 64 * 64 * 2 * 4, SSMP_BB = 2 * 64 * 64 * 2 * 4;
constexpr size_t WS_XBF  = 73 * MiB;
constexpr size_t WS_SS0  = 106 * MiB;
constexpr size_t WS_SSP  = 107 * MiB;
constexpr size_t WS_HID  = 109 * MiB;
constexpr size_t WS_OG   = WS_HID;
constexpr size_t WS_LSE  = WS_HID + 48 * MiB;
constexpr size_t WS_YA   = WS_HID + 49 * MiB;
constexpr size_t WS_XR   = 199 * MiB;
constexpr size_t WS_U    = 264 * MiB;
constexpr size_t WS_HS   = 296 * MiB;
constexpr size_t WS_SST  = 304 * MiB;
constexpr size_t WS_Q    = 320 * MiB, WS_K = 345 * MiB, WS_V = 370 * MiB;
constexpr size_t WS_TB   = WS_Q;
constexpr size_t WS_GA   = 395 * MiB, WS_GB = 428 * MiB;
constexpr size_t WS_YSM  = 461 * MiB;
constexpr size_t WS_OB   = 494 * MiB;
constexpr size_t WS_US   = 503 * MiB;
constexpr size_t WS_END  = 504 * MiB;
constexpr size_t WS_SSPS = WS_US + 384 * 1024;
static_assert(WS_U + (size_t)NG * 512 * 512 * 2 <= WS_HS && WS_HS + (size_t)NG * 512 * 128 * 2 <= WS_SST && WS_SST + (size_t)NG * 512 * 128 * 4 <= WS_Q, "ws map 0");
static_assert(WS_BH + (size_t)NG * 512 * 128 * 2 <= WS_W1T && WS_OG + (size_t)3 * MPR * SW * 4 <= WS_LSE && WS_LSE + (size_t)3 * MPR * 16 <= WS_YA && WS_US + (size_t)NSMP * DM * 4 <= WS_END, "ws map 00");
static_assert(WS_HID + (size_t)MP * FF * 2 <= WS_XR && WS_YA + (size_t)MP * DM * 2 <= WS_XR && WS_XR + (size_t)MP * DM * 4 <= WS_U, "ws map");
static_assert(WS_Q + (size_t)MP * AW * 2 <= WS_K && WS_V + (size_t)MP * AW * 2 <= WS_GA && WS_TB + (size_t)MP * DM * 2 <= WS_V, "ws map 2");
static_assert(WS_GA + (size_t)MP * DM * 2 <= WS_GB && WS_GB + (size_t)MP * DM * 2 <= WS_YSM && WS_YSM + (size_t)MP * DM * 2 <= WS_OB && WS_OB + (size_t)MP * SW * 2 <= WS_US, "ws map 3");
static_assert(WS_XBF + (size_t)MP * DM * 2 <= WS_SS0 && WS_SS0 + (size_t)MP * 4 <= WS_SSP && WS_SSP + (size_t)MP * 64 <= WS_HID, "ws map 4");
static_assert(WS_KT + 64 * KT_STRIDE <= WS_BH && WS_W1T + 64 * 128 * 1024 + 256 * 1024 <= WS_SSMP, "ws map 5");

constexpr int CW_BAR = 4096;
constexpr int CW_DYN = 24576;

constexpr int RING_BYTES = 131072;
constexpr int LDSCTL_OFF = RING_BYTES, MISC_OFF = LDSCTL_OFF + 320;
constexpr int LDS_BYTES = 147456;

typedef GAS unsigned gu32;
#define LDS_WAIT() asm volatile("s_waitcnt lgkmcnt(0)" ::: "memory")
#define VM_WAIT() asm volatile("s_waitcnt vmcnt(0)" ::: "memory")
__device__ __forceinline__ unsigned f2bf(float f) { unsigned u = __builtin_bit_cast(unsigned, f); return (u + 0x7fffu + ((u >> 16) & 1u)) >> 16; }
__device__ __forceinline__ unsigned pk2(float lo, float hi) { return f2bf(lo) | (f2bf(hi) << 16); }
__device__ __forceinline__ float bf2f(unsigned short b) { return __builtin_bit_cast(float, (unsigned)b << 16); }
__device__ __forceinline__ float bflo(unsigned w) { return __builtin_bit_cast(float, w << 16); }
__device__ __forceinline__ float bfhi(unsigned w) { return __builtin_bit_cast(float, w & 0xffff0000u); }
typedef __bf16 bf16x2_t __attribute__((ext_vector_type(2)));
__device__ __forceinline__ unsigned cvt_pk_bf16(float lo, float hi) { const f32x2 v = {lo, hi}; const bf16x2_t b = __builtin_convertvector(v, bf16x2_t); return __builtin_bit_cast(unsigned, b); }
__device__ __forceinline__ float fast_rcp(float x) { return __builtin_amdgcn_rcpf(x); }
__device__ __forceinline__ float fast_exp2(float x) { return __builtin_amdgcn_exp2f(x); }
__device__ __forceinline__ float sigmoidf_(float x) { return fast_rcp(1.0f + fast_exp2(-1.4426950408889634f * x)); }
__device__ __forceinline__ float gelu_tanh(float x) {
    const float u = 0.7978845608028654f * (x + 0.044715f * x * x * x);
    return x * sigmoidf_(2.0f * u);
}

#define XB_TMO      128
#define XB_XCNT(j)  (256  + 64 * (j))
#define XB_XSUB(j)  (1280 + 64 * (j))
#define XB_XGEN(j)  (2304 + 64 * (j))
#define XB_TOP      3328
#define XB_TOPGEN   3392
#define XCD_BAR_WORDS 3456
#define XB_SPIN_CAP (1u << 18)
__device__ __forceinline__ unsigned xb_ld(unsigned* p)              { return __hip_atomic_load(p, __ATOMIC_RELAXED, __HIP_MEMORY_SCOPE_AGENT); }
__device__ __forceinline__ unsigned xb_add(unsigned* p, unsigned v) { return __hip_atomic_fetch_add(p, v, __ATOMIC_RELAXED, __HIP_MEMORY_SCOPE_AGENT); }
__device__ __forceinline__ unsigned xb_xcc_id() { return (unsigned)__builtin_amdgcn_s_getreg((3 << 11) | 20) & 0xFu; }
#define XB_SPIN(cond, bar) do { unsigned _sp = 0; while (cond) { __builtin_amdgcn_s_sleep(1); \
    if ((++_sp & 255u) == 0u) { if (xb_ld(&(bar)[XB_TMO])) break; if (_sp > XB_SPIN_CAP) { atomicAdd(&(bar)[XB_TMO], 1u); break; } } } } while (0)
struct XcdBarrier { unsigned* bar; unsigned x; volatile LAS unsigned* st; };
__device__ __forceinline__ XcdBarrier xcd_barrier_post(unsigned* bar, volatile LAS unsigned* st) {
    XcdBarrier b; b.bar = bar; b.x = xb_xcc_id(); b.st = st;
    if (threadIdx.x == 0) (void)xb_add(&bar[XB_XCNT(b.x)], 1u);
    return b;
}
__device__ __forceinline__ void xcd_barrier_complete(unsigned* bar, unsigned x, unsigned& nloc, unsigned& nx) {
    const unsigned G = gridDim.x * gridDim.y * gridDim.z;
    unsigned sum, cnt, mine, sp = 0u;
    for (;;) {
        sum = 0u; cnt = 0u; mine = 0u;
#pragma unroll
        for (unsigned j = 0; j < 16; ++j) { const unsigned c = xb_ld(&bar[XB_XCNT(j)]); sum += c; cnt += (c > 0u) ? 1u : 0u; mine = (j == x) ? c : mine; }
        if (sum == G) break;
        __builtin_amdgcn_s_sleep(1);
        if ((++sp & 255u) == 0u) { if (xb_ld(&bar[XB_TMO])) break; if (sp > XB_SPIN_CAP) { atomicAdd(&bar[XB_TMO], 1u); break; } }
    }
    nloc = mine > 0u ? mine : 1u; nx = cnt > 0u ? cnt : 1u;
}
__device__ __forceinline__ void xcd_barrier(const XcdBarrier& b) {
    asm volatile("s_waitcnt vmcnt(0)" ::: "memory");
    __syncthreads();
    if (threadIdx.x == 0) {
        unsigned* bar = b.bar;
        __builtin_amdgcn_s_waitcnt(0);
        unsigned nloc = b.st[0], nx = b.st[1];
        if (nloc == 0u) { xcd_barrier_complete(bar, b.x, nloc, nx); b.st[0] = nloc; b.st[1] = nx; }
        const unsigned old = xb_add(&bar[XB_XSUB(b.x)], 1u);
        const unsigned gen = old / nloc;
        if (old + 1u == (gen + 1u) * nloc) {
            __builtin_amdgcn_fence(__ATOMIC_RELEASE, "agent");
            asm volatile("s_waitcnt vmcnt(0)" ::: "memory");
            const unsigned og = xb_add(&bar[XB_TOP], 1u);
            const unsigned tg = og / nx;
            __builtin_amdgcn_fence(__ATOMIC_ACQUIRE, "agent");
            if (og + 1u == (tg + 1u) * nx) xb_add(&bar[XB_TOPGEN], 1u);
            else XB_SPIN(xb_ld(&bar[XB_TOPGEN]) == tg, bar);
            xb_add(&bar[XB_XGEN(b.x)], 1u);
            asm volatile("s_waitcnt vmcnt(0)" ::: "memory");
        } else {
            __builtin_amdgcn_fence(__ATOMIC_ACQUIRE, "agent");
            XB_SPIN(xb_ld(&bar[XB_XGEN(b.x)]) == gen, bar);
            asm volatile("s_waitcnt vmcnt(0)" ::: "memory");
        }
    }
    __syncthreads();
}

namespace ge {
constexpr int BM = 256, BK = 64, HALF = 128, HTB = HALF * BK * 2;
__host__ __device__ __forceinline__ int lds_byte(int r, int c) { const int st = (r >> 4) * 2 + (c >> 5), rr = r & 15, cc = c & 31, ob = rr * 64 + cc * 2; return st * 1024 + (ob ^ (((ob >> 9) & 1) << 5)); }
__host__ __device__ __forceinline__ void stage_rc(int b, int& R, int& C) { const int st = b / 1024, sb = b % 1024, swz = sb ^ (((sb >> 9) & 1) << 5); R = (st >> 1) * 16 + swz / 64; C = (st & 1) * 32 + (swz % 64) / 2; }
__host__ __device__ __forceinline__ int perm32(int rho) { const int n = rho >> 4, i = rho & 15; return 8 * (i >> 2) + 4 * n + (i & 3); }

struct Seg { const char* A; const char* B; int nt, flags, geo, pm, pn, aux, bjmask; };
struct GeoDesc { int lda, ldb, toep, bdup; };

template <class Epi, class Sched, int NGEO, bool DRAIN = false>
__device__ __forceinline__ void gemm_phase(LAS unsigned char* lds, const Sched& S, const Epi& E, const GeoDesc (&gd)[NGEO]) {
    const int tid = threadIdx.x, wid = __builtin_amdgcn_readfirstlane(tid >> 6), lane = tid & 63, wr = wid >> 2, wc = wid & 3, fr = lane & 15, fq = lane >> 4;
    unsigned vA[NGEO][2], vB[NGEO][2]; int kstB[NGEO], hsA[NGEO], hsB[NGEO];
#pragma unroll
    for (int g = 0; g < NGEO; ++g) {
#pragma unroll
        for (int i = 0; i < 2; ++i) { int R, C; stage_rc(tid * 16 + i * 8192, R, C); const int Rb = (R & ~31) + perm32(R & 31);
            vA[g][i] = (unsigned)(R * gd[g].lda + C * 2);
            vB[g][i] = gd[g].toep ? (unsigned)((((Rb >> 4) - (C >> 4) + 15) * 256 + (Rb & 15) * 16 + (C & 15)) * 2) : (unsigned)(Rb * gd[g].ldb + C * 2); }
        kstB[g] = gd[g].toep ? -2048 : 128; hsA[g] = HALF * gd[g].lda; hsB[g] = gd[g].toep ? 4096 : (gd[g].bdup ? 0 : HALF * gd[g].ldb);
    }
    const unsigned ldsw = (unsigned)wid * 1024u;
    const int aoff = lds_byte(wr * 64 + fr, fq * 8), boff = lds_byte(wc * 32 + fr, fq * 8);
#define GE_SA(b, h) (((b) * 2 + (h)) * HTB)
#define GE_SB(b, h) ((4 + (b) * 2 + (h)) * HTB)
#define GE_VA(g, i) (NGEO == 1 ? vA[0][i] : ((g) ? vA[NGEO - 1][i] : vA[0][i]))
#define GE_VB(g, i) (NGEO == 1 ? vB[0][i] : ((g) ? vB[NGEO - 1][i] : vB[0][i]))
#define GE_KSB(g) (NGEO == 1 ? kstB[0] : ((g) ? kstB[NGEO - 1] : kstB[0]))
#define GE_HSA(g) (NGEO == 1 ? hsA[0] : ((g) ? hsA[NGEO - 1] : hsA[0]))
#define GE_HSB(g) (NGEO == 1 ? hsB[0] : ((g) ? hsB[NGEO - 1] : hsB[0]))
#define GE_STAGE(bufoff, gbase, v0, v1) do { \
        __builtin_amdgcn_global_load_lds((const unsigned*)((const char*)(gbase) + (v0)), (LAS unsigned*)(lds + (bufoff) + ldsw), 16, 0, 0); \
        __builtin_amdgcn_global_load_lds((const unsigned*)((const char*)(gbase) + (v1)), (LAS unsigned*)(lds + (bufoff) + ldsw + 8192), 16, 0, 0); } while (0)
#define GE_STAGE_A(bufoff, gbase, g) GE_STAGE(bufoff, gbase, GE_VA(g, 0), GE_VA(g, 1))
#define GE_STAGE_B(bufoff, gbase, g) GE_STAGE(bufoff, gbase, GE_VB(g, 0), GE_VB(g, 1))
#define GE_LDA(dst, b, h) do { _Pragma("unroll") for (int m = 0; m < 4; ++m) _Pragma("unroll") for (int k = 0; k < 2; ++k) dst[m][k] = *(const LAS bf16x8*)(lds + GE_SA(b, h) + aoff + m * 2048 + k * 1024); } while (0)
#define GE_LDB(dst, b, h) do { _Pragma("unroll") for (int n = 0; n < 2; ++n) _Pragma("unroll") for (int k = 0; k < 2; ++k) dst[n][k] = *(const LAS bf16x8*)(lds + GE_SB(b, h) + boff + n * 2048 + k * 1024); } while (0)
#define GE_MMA(ai, bj, At, Bt) do { __builtin_amdgcn_s_setprio(1); _Pragma("unroll") for (int m = 0; m < 4; ++m) _Pragma("unroll") for (int n = 0; n < 2; ++n) _Pragma("unroll") for (int k = 0; k < 2; ++k) \
        acc[ai][bj][m][n] = __builtin_amdgcn_mfma_f32_16x16x32_bf16(Bt[n][k], At[m][k], acc[ai][bj][m][n], 0, 0, 0); __builtin_amdgcn_s_setprio(0); } while (0)
#define GE_WAIT_V(n) asm volatile("s_waitcnt vmcnt(" #n ")" ::: "memory")
#define GE_WAIT_L(n) asm volatile("s_waitcnt lgkmcnt(" #n ")" ::: "memory")
#define GE_BAR __builtin_amdgcn_s_barrier()
#define GE_SCHED __builtin_amdgcn_sched_barrier(0)
    Seg cur, nxt; int si = 0;
    if (!S.seg(0, cur)) return;
    f32x4 acc[2][2][4][2];
#pragma unroll
    for (int a = 0; a < 2; ++a)
#pragma unroll
        for (int b = 0; b < 2; ++b)
#pragma unroll
            for (int m = 0; m < 4; ++m)
#pragma unroll
                for (int n = 0; n < 2; ++n) acc[a][b][m][n] = (f32x4){0.f, 0.f, 0.f, 0.f};
    bf16x8 At[4][2], B0[2][2], B1[2][2];
    const char* cA = cur.A; const char* cB = cur.B; int cg = cur.geo;
    {
        GE_STAGE_B(GE_SB(0, 0), cB, cg); GE_STAGE_B(GE_SB(0, 1), cB + GE_HSB(cg), cg); GE_STAGE_A(GE_SA(0, 0), cA, cg); GE_STAGE_A(GE_SA(0, 1), cA + GE_HSA(cg), cg);
        if (wr == 1) GE_BAR;
        GE_WAIT_V(2); GE_BAR;
        GE_STAGE_B(GE_SB(1, 0), cB + GE_KSB(cg), cg); GE_STAGE_A(GE_SA(1, 0), cA + 128, cg); GE_STAGE_B(GE_SB(1, 1), cB + GE_HSB(cg) + GE_KSB(cg), cg);
        GE_WAIT_V(6); GE_BAR;
    }
    for (;;) {
        const bool has_next = S.seg(si + 1, nxt);
        const char* nA = has_next ? nxt.A : cA; const char* nB = has_next ? nxt.B : cB; const int ng = has_next ? nxt.geo : cg;
        const int nt = cur.nt;
        for (int t = 0; t < nt; t += 2) {
            const bool last = (t == nt - 2);
            const int g2 = last ? ng : cg;
            const char* a1 = cA + (size_t)(t + 1) * 128;
            const char* a2 = last ? nA : cA + (size_t)(t + 2) * 128;
            const char* b2 = last ? nB : cB + (long)(t + 2) * GE_KSB(cg);
            const char* a3 = a2 + 128; const char* b3 = b2 + GE_KSB(g2);
            GE_LDB(B0, 0, 0); GE_LDB(B1, 0, 1); GE_SCHED; GE_LDA(At, 0, 0); GE_STAGE_A(GE_SA(1, 1), a1 + GE_HSA(cg), cg);
            GE_WAIT_V(8); GE_WAIT_L(0); GE_BAR; GE_MMA(0, 0, At, B0); GE_MMA(0, 1, At, B1); GE_BAR; GE_SCHED;
            GE_LDA(At, 0, 1); GE_STAGE_B(GE_SB(0, 0), b2, g2); GE_STAGE_B(GE_SB(0, 1), b2 + GE_HSB(g2), g2); GE_STAGE_A(GE_SA(0, 0), a2, g2);
            GE_WAIT_V(8); GE_WAIT_L(0); GE_BAR; GE_MMA(1, 0, At, B0); GE_MMA(1, 1, At, B1); GE_BAR; GE_SCHED;
            GE_LDB(B0, 1, 0); GE_LDB(B1, 1, 1); GE_SCHED; GE_LDA(At, 1, 0); GE_STAGE_A(GE_SA(0, 1), a2 + GE_HSA(g2), g2);
            GE_WAIT_V(8); GE_WAIT_L(0); GE_BAR; GE_MMA(0, 0, At, B0); GE_MMA(0, 1, At, B1); GE_BAR; GE_SCHED;
            GE_LDA(At, 1, 1); GE_STAGE_B(GE_SB(1, 0), b3, g2); GE_STAGE_B(GE_SB(1, 1), b3 + GE_HSB(g2), g2); GE_STAGE_A(GE_SA(1, 0), a3, g2);
            GE_WAIT_V(8); GE_WAIT_L(0); GE_BAR; GE_MMA(1, 0, At, B0); GE_MMA(1, 1, At, B1); GE_BAR; GE_SCHED;
        }
        const bool epi = (cur.flags & 1) != 0;
        if (epi) {
            if (wr == 0) GE_BAR;
            if (!(DRAIN && !has_next)) E.template run<2, 4>(acc, cur, wr, wc, fr, fq);
        }
        if (!has_next) break;
        if (epi) {
#pragma unroll
            for (int a = 0; a < 2; ++a)
#pragma unroll
                for (int b = 0; b < 2; ++b)
#pragma unroll
                    for (int m = 0; m < 4; ++m)
#pragma unroll
                        for (int n = 0; n < 2; ++n) acc[a][b][m][n] = (f32x4){0.f, 0.f, 0.f, 0.f};
        }
        cur = nxt; cA = nA; cB = nB; cg = ng; ++si;
        if (epi) { if (wr == 1) GE_BAR; }
    }
    GE_WAIT_V(0);
    GE_BAR;
    if constexpr (DRAIN) E.drain(acc, cur, wr, wc, fr, fq, lds);
#undef GE_SA
#undef GE_SB
#undef GE_VA
#undef GE_VB
#undef GE_KSB
#undef GE_HSA
#undef GE_HSB
#undef GE_STAGE
#undef GE_STAGE_A
#undef GE_STAGE_B
#undef GE_LDA
#undef GE_LDB
#undef GE_MMA
#undef GE_WAIT_V
#undef GE_WAIT_L
#undef GE_BAR
#undef GE_SCHED
}

struct StdSched {
    const char* A; const char* B; size_t atile, btile; int nM, nN, nt, nwg, G, c;
    __device__ void init(const void* A_, int lda, const void* B_, int ldb, int M, int N, int K, int G_, int c_) {
        A = (const char*)A_; B = (const char*)B_; atile = (size_t)BM * lda; btile = (size_t)BM * ldb; nM = M / BM; nN = N / BM; nt = K / BK; nwg = nM * nN; G = G_; c = c_; }
    __device__ __forceinline__ bool seg(int i, Seg& s) const {
        const long L = (long)i * G + c; if (L >= nwg) return false;
        int wgid = (int)L; { const int q = nwg / 8, r = nwg % 8, xcd = wgid % 8, off = wgid / 8; wgid = (xcd < r ? xcd * (q + 1) : r * (q + 1) + (xcd - r) * q) + off; }
        const int nig = 4 * nN, gid = wgid / nig, fm = gid * 4, gsz = (nM - fm) < 4 ? (nM - fm) : 4;
        const int pm = fm + ((wgid % nig) % gsz), pn = (wgid % nig) / gsz;
        s.A = A + (size_t)pm * atile; s.B = B + (size_t)pn * btile; s.nt = nt; s.flags = 1; s.geo = 0; s.pm = pm; s.pn = pn; s.aux = i; s.bjmask = 3; return true;
    }
};
}

struct Args { const float* in[31]; float* out; unsigned char* ws; int ph_lo, ph_hi; };
struct Frame {
    LAS unsigned char* lds;
    int tid, lane, wave, G, bid;
    const Args* a;
    float* out;
    unsigned char* ws;
};
#define FIN(k) (F.a->in[k])
__device__ __forceinline__ float wave_sum(float v) {
#pragma unroll
    for (int o = 1; o < 64; o <<= 1) v += __shfl_xor(v, o);
    return v;
}
__device__ __forceinline__ float wave_max(float v) {
#pragma unroll
    for (int o = 1; o < 64; o <<= 1) v = fmaxf(v, __shfl_xor(v, o));
    return v;
}

constexpr int KVR0 = 32 * 127, KVR1 = KVR0 + 32 * 511, KVNR = KVR1 + 32 * 2047;
constexpr int BGW_P0 = 6, BGW_T = 24, BGW_T1 = 8, BGW_T10 = 28, BGW_XS = 0, BGW_XA = 13;
constexpr int BGW_S2 = 4, BGW_S7 = 3, BGW_S8 = 3, BGW_S9 = 3, BGW_S11 = 4, BG_NF = 224;
constexpr int BGO_P0 = 0, BGO_P1 = BGO_P0 + 256 * BGW_P0, BGO_P3 = BGO_P1 + 128 * BGW_T1, BGO_XS = BGO_P3 + 192 * BGW_T, BGO_XA = BGO_XS + 128 * BGW_XS,
              BGO_P10 = BGO_XA + 128 * BGW_XA, BGO_S2 = BGO_P10 + 128 * BGW_T10, BGO_S7 = BGO_S2 + BG_NF * BGW_S2, BGO_S8 = BGO_S7 + BG_NF * BGW_S7,
              BGO_S9 = BGO_S8 + BG_NF * BGW_S8, BGO_S11 = BGO_S9 + BG_NF * BGW_S9, BGW_TOT = BGO_S11 + BG_NF * BGW_S11;
__device__ __forceinline__ void kv_row_ptrs(Frame& F, int rho, const GAS f32x4*& src, GAS f32x4*& dst) {
    const int g = rho < KVR0 ? 0 : (rho < KVR1 ? 1 : 2);
    const int e = rho - (g == 0 ? 0 : (g == 1 ? KVR0 : KVR1)), Wm1 = (128 << (2 * g)) - 1, sb = e / Wm1, rr = e - sb * Wm1;
    const size_t ro = ((size_t)sb * (Wm1 + 1) + rr) * 128;
    src = (const GAS f32x4*)FIN(4 + g) + ro + 128; dst = (GAS f32x4*)(F.out + (g == 0 ? O_SKV0 : g == 1 ? O_SKV1 : O_SKV2)) + ro;
}
__device__ __forceinline__ void bg_copy(Frame& F, int wlo, int whi, int rank, int nw) {
    const int r_lo = (int)((long)KVNR * wlo / BGW_TOT), r_hi = (int)((long)KVNR * whi / BGW_TOT);
    for (int r0 = r_lo + 8 * rank; r0 < r_hi; r0 += 8 * nw) {
        f32x4 t[16]; GAS f32x4* dp[8];
#pragma unroll
        for (int k = 0; k < 8; ++k) { const int rho = (r0 + k < r_hi) ? r0 + k : r_lo; const GAS f32x4* sp; kv_row_ptrs(F, rho, sp, dp[k]); if (r0 + k >= r_hi) dp[k] = nullptr;
            t[2 * k] = __builtin_nontemporal_load(sp + F.lane); t[2 * k + 1] = __builtin_nontemporal_load(sp + 64 + F.lane); }
#pragma unroll
        for (int k = 0; k < 8; ++k) if (dp[k]) { __builtin_nontemporal_store(t[2 * k], dp[k] + F.lane); __builtin_nontemporal_store(t[2 * k + 1], dp[k] + 64 + F.lane); }
    }
}


__device__ __forceinline__ void p0_transpose_item(const float* W, int K, int N, bf16* WT, int drow0, LAS float* scr, int k0, int n0, const float* scale, int lane) {
    float wv[32];
#pragma unroll
    for (int i = 0; i < 32; ++i) { const int kk = 2 * i + (lane >> 5); wv[i] = __builtin_nontemporal_load(W + (size_t)(k0 + kk) * N + n0 + (lane & 31)); }
    if (scale) {
#pragma unroll
        for (int i = 0; i < 32; ++i) wv[i] *= scale[k0 + 2 * i + (lane >> 5)];
    }
#pragma unroll
    for (int i = 0; i < 32; ++i) scr[(2 * i + (lane >> 5)) * 33 + (lane & 31)] = wv[i];
    LDS_WAIT(); asm volatile("" ::: "memory");
    const int c = lane & 7;
#pragma unroll
    for (int j = 0; j < 4; ++j) { const int n = (lane >> 3) + 8 * j; const LAS float* s = scr + (8 * c) * 33 + n;
        u32x4 o; o.x = pk2(s[0 * 33], s[1 * 33]); o.y = pk2(s[2 * 33], s[3 * 33]); o.z = pk2(s[4 * 33], s[5 * 33]); o.w = pk2(s[6 * 33], s[7 * 33]);
        *(GAS u32x4*)(WT + (size_t)(drow0 + n) * K + k0 + 8 * c) = o; }
    LDS_WAIT(); asm volatile("" ::: "memory");
}
__device__ __forceinline__ int rmap_ident(int n0) { return n0; }
__device__ __forceinline__ int rmap_gate(int n0) { return 256 * (n0 >> 7) + (n0 & 127); }
__device__ __forceinline__ int rmap_up(int n0) { return 256 * (n0 >> 7) + 128 + (n0 & 127); }
__device__ __forceinline__ int rmap_win(int n0) { const int cl = n0 & 255; return (n0 & ~255) + 128 * ((cl & 63) >> 5) + 32 * (cl >> 6); }

__device__ __forceinline__ void sincos_rev(float r, float& s, float& c) {
    const float q = rintf(4.0f * r); const float f = r - 0.25f * q;
    const float x = f * 6.283185307179586f, z = x * x;
    const float sp = x + x * z * (-1.6666654611e-1f + z * (8.3321608736e-3f + z * (-1.9515295891e-4f)));
    const float cp = 1.0f - 0.5f * z + z * z * (4.166664568298827e-2f + z * (-1.388731625493765e-3f + z * 2.443315711809948e-5f));
    const int qi = ((int)q) & 3;
    s = (qi == 0) ? sp : (qi == 1) ? cp : (qi == 2) ? -sp : -cp;
    c = (qi == 0) ? cp : (qi == 1) ? -sp : (qi == 2) ? -cp : sp;
}
struct SsmP { float a, rb, fr, fi; };
__device__ __forceinline__ SsmP ssm_param(const Frame& F, int g, int p) {
    const float lr = fminf(FIN(13)[g * 64 + p], -1e-4f), li = FIN(14)[g * 64 + p];
    const float dt = __expf(FIN(20)[g]);
    SsmP o; o.a = lr * dt; const float b = li * dt; o.rb = b * 0.15915494309189535f;
    float s, c; sincos_rev(o.rb, s, c);
    const float a = o.a;
    const float em1 = (fabsf(a) < 0.1f) ? a * (1.0f + a * (0.5f + a * (0.16666667f + a * (0.041666668f + a * (0.0083333338f + a * 0.0013888889f))))) : (__expf(a) - 1.0f);
    float sh, chh; sincos_rev(0.5f * o.rb, sh, chh);
    const float cm1 = -2.0f * sh * sh;
    const float nr = em1 * c + cm1, ni = (em1 + 1.0f) * s;
    const float den = lr * lr + li * li;
    o.fr = (nr * lr + ni * li) / den; o.fi = (ni * lr - nr * li) / den;
    return o;
}
__device__ __forceinline__ void ssm_pow(const SsmP& P, int k, float& re, float& im) {
    const float mag = __expf(P.a * (float)k); float s, c; sincos_rev(P.rb * (float)k, s, c); re = mag * c; im = mag * s;
}
__device__ __forceinline__ void p0_ssm_task(const Frame& F, int g, int j, LAS float* scr) {
    const int lane = F.lane, p = lane;
    const SsmP P = ssm_param(F, g, p);
    const float* bre = FIN(15) + (size_t)(g * 64 + p) * 16; const float* bim = FIN(16) + (size_t)(g * 64 + p) * 16;
    float bbr[16], bbi[16];
#pragma unroll
    for (int c = 0; c < 16; ++c) { const float br = bre[c], bi = bim[c]; bbr[c] = P.fr * br - P.fi * bi; bbi[c] = P.fr * bi + P.fi * br; }
    bf16* KT = (bf16*)(F.ws + WS_KT) + (size_t)g * (KT_STRIDE / 2);
    bf16* BH = (bf16*)(F.ws + WS_BH) + (size_t)g * 512 * 128;
    bf16* W1T = (bf16*)(F.ws + WS_W1T) + (size_t)g * 128 * 512;
    { float ar, ai; ssm_pow(P, j, ar, ai);
#pragma unroll
      for (int c = 0; c < 16; ++c) { scr[p * 16 + c] = ar * bbr[c] - ai * bbi[c]; scr[1024 + p * 16 + c] = ar * bbi[c] + ai * bbr[c]; }
      LDS_WAIT(); asm volatile("" ::: "memory");
      const int co = lane >> 2, ci = 4 * (lane & 3);
      const float* cre = FIN(17) + (size_t)(g * 16 + co) * 64; const float* cim = FIN(18) + (size_t)(g * 16 + co) * 64;
      f32x4 acc = (f32x4){0.f, 0.f, 0.f, 0.f};
      for (int pp = 0; pp < 64; ++pp) { const float cr = cre[pp], cii = cim[pp];
          const f32x4 er = *(const LAS f32x4*)(scr + pp * 16 + ci), ei = *(const LAS f32x4*)(scr + 1024 + pp * 16 + ci);
          acc += cr * er - cii * ei; }
      if (j == 0) { const float dv = FIN(19)[g * 16 + co];
#pragma unroll
          for (int k = 0; k < 4; ++k) if (ci + k == co) acc[k] += dv; }
      u32x2 o; o.x = pk2(acc[0], acc[1]); o.y = pk2(acc[2], acc[3]);
      *(GAS u32x2*)(KT + (size_t)(j + 15) * 256 + co * 16 + ci) = o;
      LDS_WAIT(); asm volatile("" ::: "memory");
    }
    { float ar, ai; ssm_pow(P, j + 1, ar, ai);
#pragma unroll 4
      for (int co = 0; co < 16; ++co) { const float cr = FIN(17)[(size_t)(g * 16 + co) * 64 + p], cii = FIN(18)[(size_t)(g * 16 + co) * 64 + p];
          bf16* row = BH + (size_t)(j * 16 + co) * 128;
          row[p] = (bf16)f2bf(cr * ar - cii * ai); row[64 + p] = (bf16)f2bf(-(cr * ai + cii * ar)); }
    }
    { float ar, ai; ssm_pow(P, 31 - j, ar, ai);
      u32x4 r0, r1, i0, i1; float er[16], ei[16];
#pragma unroll
      for (int c = 0; c < 16; ++c) { er[c] = ar * bbr[c] - ai * bbi[c]; ei[c] = ar * bbi[c] + ai * bbr[c]; }
      r0.x = pk2(er[0], er[1]); r0.y = pk2(er[2], er[3]); r0.z = pk2(er[4], er[5]); r0.w = pk2(er[6], er[7]);
      r1.x = pk2(er[8], er[9]); r1.y = pk2(er[10], er[11]); r1.z = pk2(er[12], er[13]); r1.w = pk2(er[14], er[15]);
      i0.x = pk2(ei[0], ei[1]); i0.y = pk2(ei[2], ei[3]); i0.z = pk2(ei[4], ei[5]); i0.w = pk2(ei[6], ei[7]);
      i1.x = pk2(ei[8], ei[9]); i1.y = pk2(ei[10], ei[11]); i1.z = pk2(ei[12], ei[13]); i1.w = pk2(ei[14], ei[15]);
      GAS u32x4* wr_ = (GAS u32x4*)(W1T + (size_t)p * 512 + j * 16); wr_[0] = r0; wr_[1] = r1;
      GAS u32x4* wi_ = (GAS u32x4*)(W1T + (size_t)(64 + p) * 512 + j * 16); wi_[0] = i0; wi_[1] = i1;
    }
    if (j == 0) {
        for (int q = lane; q < 480; q += 64) ((GAS u32x4*)KT)[q] = (u32x4){0u, 0u, 0u, 0u};
        float* sp = (float*)(F.ws + WS_SSMP);
        float ar, ai; ssm_pow(P, 32, ar, ai);
        sp[SSMP_A32 / 4 + (g * 64 + p) * 2] = ar; sp[SSMP_A32 / 4 + (g * 64 + p) * 2 + 1] = ai;
        ssm_pow(P, 1, ar, ai);
        sp[SSMP_A1 / 4 + (g * 64 + p) * 2] = ar; sp[SSMP_A1 / 4 + (g * 64 + p) * 2 + 1] = ai;
#pragma unroll
        for (int c = 0; c < 16; ++c) { sp[SSMP_BB / 4 + ((size_t)(g * 64 + p) * 16 + c) * 2] = bbr[c]; sp[SSMP_BB / 4 + ((size_t)(g * 64 + p) * 16 + c) * 2 + 1] = bbi[c]; }
    }
}
constexpr int P0I_G = (DM / 64) * (FF / 32), P0I_D = (FF / 64) * (DM / 32), P0I_IN = (DM / 64) * (NIN / 32), P0I_SQ = (DM / 64) * (DM / 32), P0I_PB = (SW / 64) * (DM / 32);
constexpr int P0_NITEMS = 4 * P0I_G + 2 * P0I_D + P0I_IN + 3 * P0I_SQ + P0I_PB, P0_LATE = 2 * P0I_G + P0I_D;
__device__ __forceinline__ void p0_weights(Frame& F, int lo, int hi, int gw, int NGW) {
    LAS float* scr = (LAS float*)(F.lds + F.wave * 16384);
    constexpr int I_G = P0I_G, I_D = P0I_D, I_IN = P0I_IN, I_SQ = P0I_SQ, I_PB = P0I_PB;
    for (int it = lo + gw; it < hi; it += NGW) {
        int r = it;
#define TR_ITEM(cnt, W_, K_, N_, WT_, rmap, scale_) if (r < (cnt)) { const int nblk = (N_) / 32, kb = r / nblk, nb = r % nblk; \
            p0_transpose_item(W_, K_, N_, (bf16*)(F.ws + (WT_)), rmap(32 * nb), scr, 64 * kb, 32 * nb, scale_, F.lane); continue; } r -= (cnt);
        TR_ITEM(I_G, FIN(8), DM, FF, WS_WGU1, rmap_gate, FIN(7))
        TR_ITEM(I_G, FIN(9), DM, FF, WS_WGU1, rmap_up, FIN(7))
        TR_ITEM(I_D, FIN(10), FF, DM, WS_WD1, rmap_ident, nullptr)
        TR_ITEM(I_IN, FIN(12), DM, NIN, WS_WIN, rmap_win, FIN(11))
        TR_ITEM(I_SQ, FIN(21), DM, DM, WS_WGLU, rmap_ident, nullptr)
        TR_ITEM(I_SQ, FIN(24), DM, DM, WS_WPA, rmap_ident, nullptr)
        TR_ITEM(I_SQ, FIN(26), DM, DM, WS_WOUT, rmap_ident, nullptr)
        TR_ITEM(I_PB, FIN(25), SW, DM, WS_WPB, rmap_ident, nullptr)
        TR_ITEM(I_G, FIN(28), DM, FF, WS_WGU2, rmap_gate, FIN(27))
        TR_ITEM(I_G, FIN(29), DM, FF, WS_WGU2, rmap_up, FIN(27))
        TR_ITEM(I_D, FIN(30), FF, DM, WS_WD2, rmap_ident, nullptr)
#undef TR_ITEM
    }
}
__device__ __forceinline__ void p0_prologue(Frame& F) {
    LAS float* scr = (LAS float*)(F.lds + F.wave * 16384);
    const int gw = F.bid * NWAVES + F.wave, NGW = F.G * NWAVES;
    p0_weights(F, 0, F.G == 256 ? P0_NITEMS - P0_LATE : P0_NITEMS, gw, NGW);
    {
        bf16* XB = (bf16*)(F.ws + WS_XBF); float* SS0 = (float*)(F.ws + WS_SS0);
        for (int m0 = 2 * gw; m0 < MPR + NSMP; m0 += 2 * NGW) {
            f32x4 v[2][4];
#pragma unroll
            for (int r = 0; r < 2; ++r) { const int m = m0 + r; const float* xrow = (m < MPR) ? FIN(0) + (size_t)m * DM : FIN(1) + (size_t)(m - MPR) * DM;
                const GAS f32x4* xr = (const GAS f32x4*)xrow + F.lane;
#pragma unroll
                for (int j = 0; j < 4; ++j) v[r][j] = __builtin_nontemporal_load(xr + 64 * j); }
#pragma unroll
            for (int r = 0; r < 2; ++r) { const int m = m0 + r; float s = 0.f;
#pragma unroll
                for (int j = 0; j < 4; ++j) s += (v[r][j].x * v[r][j].x + v[r][j].y * v[r][j].y) + (v[r][j].z * v[r][j].z + v[r][j].w * v[r][j].w);
                s = wave_sum(s);
                GAS u32x2* o8 = (GAS u32x2*)(XB + (size_t)m * DM) + F.lane;
#pragma unroll
                for (int j = 0; j < 4; ++j) { u32x2 o; o.x = pk2(v[r][j].x, v[r][j].y); o.y = pk2(v[r][j].z, v[r][j].w); o8[64 * j] = o; }
                if (F.lane == 0) SS0[m] = s; }
        }
    }
    for (int t = gw; t < NG * 32; t += NGW) p0_ssm_task(F, t >> 5, t & 31, scr);
    if (F.G == 256) bg_copy(F, BGO_P0 + F.bid * BGW_P0, BGO_P0 + (F.bid + 1) * BGW_P0, F.wave, NWAVES);
    else bg_copy(F, (int)((long)BGW_TOT * F.bid / F.G), (int)((long)BGW_TOT * (F.bid + 1) / F.G), F.wave, NWAVES);
}


typedef f32x4 AccT[2][2][4][2];
__device__ __forceinline__ float rsq(float x) { return __builtin_amdgcn_rsqf(x); }
__device__ __forceinline__ float row_rstd16(const float* ssp, int row) {
    const GAS f32x4* p = (const GAS f32x4*)(ssp + (size_t)row * 16);
    const f32x4 a = p[0], b = p[1], c = p[2], d = p[3];
    const float s = ((a.x + a.y) + (a.z + a.w)) + ((b.x + b.y) + (b.z + b.w)) + ((c.x + c.y) + (c.z + c.w)) + ((d.x + d.y) + (d.z + d.w));
    return rsq(s * (1.0f / DM) + RMS_EPS);
}
__device__ __forceinline__ u32x4 pack8(const f32x4& a, const f32x4& b) { u32x4 w; w.x = cvt_pk_bf16(a[0], a[1]); w.y = cvt_pk_bf16(a[2], a[3]); w.z = cvt_pk_bf16(b[0], b[1]); w.w = cvt_pk_bf16(b[2], b[3]); return w; }
__device__ __forceinline__ void unpack8(const u32x4 w, f32x4& a, f32x4& b) { a = (f32x4){bflo(w.x), bfhi(w.x), bflo(w.y), bfhi(w.y)}; b = (f32x4){bflo(w.z), bfhi(w.z), bflo(w.w), bfhi(w.w)}; }

constexpr int RSTAB_OFF = 131584, RSTAB_S_OFF = RSTAB_OFF + 8 * 1024;
static_assert(RSTAB_S_OFF + 128 <= LDS_BYTES && RSTAB_OFF >= MISC_OFF + 128, "LDS map");
template <class Sched> __device__ __forceinline__ void fill_rstd(Frame& F, const Sched& S, const float* ss, int npart) {
    LAS float* tab = (LAS float*)(F.lds + RSTAB_OFF); LAS float* tabs = (LAS float*)(F.lds + RSTAB_S_OFF);
    ge::Seg sg;
    for (int i = 0; i < 8 && S.seg(i, sg); ++i) if (F.tid < 256) { const int row = sg.pm * 256 + F.tid;
        tab[i * 256 + F.tid] = (npart == 1) ? rsq(ss[row] * (1.0f / DM) + RMS_EPS) : row_rstd16(ss, row); }
    if (F.tid < NSMP) { const int row = MPR + F.tid; float r;
        if (npart == 1) r = rsq(ss[row] * (1.0f / DM) + RMS_EPS);
        else { const GAS f32x4* pp = (const GAS f32x4*)((const float*)(F.ws + WS_SSPS) + F.tid * 32); float sm = 0.f;
#pragma unroll
            for (int k = 0; k < 8; ++k) { const f32x4 v = pp[k]; sm += (v.x + v.y) + (v.z + v.w); }
            r = rsq(sm * (1.0f / DM) + RMS_EPS); }
        tabs[F.tid] = r; }
    __syncthreads();
}
struct EpiGateUp {
    const LAS float* rs; bf16* HID; __amdgpu_buffer_rsrc_t hsr;
    template <int AI_N = 2, int M_N = 4> __device__ __forceinline__ void run(const AccT& acc, const ge::Seg& u, int wr, int wc, int fr, int fq) const {
        const int row0 = u.pm * 256 + wr * 64 + fr, col0 = u.pn * 128 + wc * 32 + 8 * fq; const LAS float* rp = rs + u.aux * 256 + wr * 64 + fr;
        float rv[AI_N][M_N];
#pragma unroll
        for (int ai = 0; ai < AI_N; ++ai)
#pragma unroll
            for (int m = 0; m < M_N; ++m) rv[ai][m] = rp[ai * 128 + m * 16];
#pragma unroll
        for (int ai = 0; ai < AI_N; ++ai)
#pragma unroll
            for (int m = 0; m < M_N; ++m) { const int row = row0 + ai * 128 + m * 16; const float rstd = rv[ai][m];
                f32x4 h[2];
#pragma unroll
                for (int n = 0; n < 2; ++n)
#pragma unroll
                    for (int i = 0; i < 4; ++i) { const float g = acc[ai][0][m][n][i] * rstd, up = acc[ai][1][m][n][i] * rstd; h[n][i] = g * sigmoidf_(g) * up; }
                __builtin_amdgcn_raw_buffer_store_b128(pack8(h[0], h[1]), hsr, (int)(((size_t)row * FF + col0) * 2), 0, 16); }
    }
};
template <bool FINAL> struct EpiResid {
    float alpha; bf16* xb; float* ssp; float* out; float* ssps;
    template <int AI_N = 2, int M_N = 4> __device__ __forceinline__ void run(const AccT& acc, const ge::Seg& u, int wr, int wc, int fr, int fq) const {
        const int row0 = u.pm * 256 + wr * 64 + fr, col0 = u.pn * 256 + wc * 32 + 8 * fq;
#pragma unroll
        for (int ai = 0; ai < AI_N; ++ai) {
            u32x4 bw[M_N][2];
#pragma unroll
            for (int m = 0; m < M_N; ++m)
#pragma unroll
                for (int bj = 0; bj < 2; ++bj) bw[m][bj] = *(const GAS u32x4*)(xb + (size_t)(row0 + ai * 128 + m * 16) * DM + col0 + bj * 128);
#pragma unroll
            for (int m = 0; m < M_N; ++m) { const int row = row0 + ai * 128 + m * 16; float sq = 0.f;
                const size_t doff = (row < MPR) ? O_YP + (size_t)row * DM : O_YS + (size_t)(row - MPR) * DM;
#pragma unroll
                for (int bj = 0; bj < 2; ++bj) if ((u.bjmask >> bj) & 1) { const size_t off = (size_t)row * DM + col0 + bj * 128;
                    f32x4 b0, b1; unpack8(bw[m][bj], b0, b1);
                    const f32x4 o0 = b0 + alpha * acc[ai][bj][m][0], o1 = b1 + alpha * acc[ai][bj][m][1];
                    if (FINAL) { __builtin_nontemporal_store(o0, (GAS f32x4*)(out + doff + col0 + bj * 128)); __builtin_nontemporal_store(o1, (GAS f32x4*)(out + doff + col0 + bj * 128 + 4)); }
                    else { *(GAS u32x4*)(xb + off) = pack8(o0, o1);
                        sq += (o0[0] * o0[0] + o0[1] * o0[1]) + (o0[2] * o0[2] + o0[3] * o0[3]) + (o1[0] * o1[0] + o1[1] * o1[1]) + (o1[2] * o1[2] + o1[3] * o1[3]); } }
                if (!FINAL) { sq += __shfl_xor(sq, 16); sq += __shfl_xor(sq, 32);
                    if (fq == 0) { if (u.bjmask == 3) ssp[(size_t)row * 16 + u.pn * 4 + wc] = sq; else ssps[(size_t)(row - MPR) * 32 + u.pn * 8 + wc * 2 + (u.bjmask >> 1)] = sq; } } }
        }
    }
};
__device__ __forceinline__ size_t qkv_off(int g, int hc, int row) {
    const int dsh = 2 * g; int ti = row;
    if (row < MPR) { const int b = row >> 12, t = row & 4095; ti = b * SEQ + (t & ((1 << dsh) - 1)) * (SEQ >> dsh) + (t >> dsh); }
    return ((size_t)(g * 4 + hc) * MP + ti) * 64;
}
struct EpiWin {
    const LAS float* rs; bf16 *U, *Q, *K, *V, *GA, *GB; float* US; const float *qg, *kg; float* out;
    __device__ __forceinline__ float* kvdst(int grp, int row, int which) const {
        const int W = 128 << (2 * grp);
        if (row < MPR) { const int b = row >> 12, t = row & 4095; if (t < SEQ - W) return nullptr;
            return out + (grp == 0 ? O_PKV0 : grp == 1 ? O_PKV1 : O_PKV2) + ((size_t)(b * W + t - (SEQ - W)) * 2 + which) * 256; }
        const int sb = row - MPR; return out + (grp == 0 ? O_SKV0 : grp == 1 ? O_SKV1 : O_SKV2) + ((size_t)(sb * W + W - 1) * 2 + which) * 256;
    }
    template <int AI_N = 2, int M_N = 4> __device__ __forceinline__ void run(const AccT& acc, const ge::Seg& u, int wr, int wc, int fr, int fq) const {
        const int row0 = u.pm * 256 + wr * 64 + fr, pn = u.pn, cl0 = 64 * wc + 8 * fq; const LAS float* rp = rs + u.aux * 256 + wr * 64 + fr;
        float rv[AI_N][M_N];
#pragma unroll
        for (int ai = 0; ai < AI_N; ++ai)
#pragma unroll
            for (int m = 0; m < M_N; ++m) rv[ai][m] = rp[ai * 128 + m * 16];
        f32x4 gn[2][2];
        if (pn >= 4 && pn < 10) { const float* gp = (pn < 7) ? qg : kg; const float sc = (pn < 7) ? 0.125f : 1.0f;
#pragma unroll
            for (int bj = 0; bj < 2; ++bj) { gn[bj][0] = *(const GAS f32x4*)(gp + 32 * bj + 8 * fq) * sc; gn[bj][1] = *(const GAS f32x4*)(gp + 32 * bj + 8 * fq + 4) * sc; } }
#pragma unroll
        for (int ai = 0; ai < AI_N; ++ai)
#pragma unroll
            for (int m = 0; m < M_N; ++m) { const int row = row0 + ai * 128 + m * 16;
                const float rstd = rv[ai][m];
                f32x4 v[2][2];
#pragma unroll
                for (int bj = 0; bj < 2; ++bj)
#pragma unroll
                    for (int n = 0; n < 2; ++n) v[bj][n] = acc[ai][bj][m][n] * rstd;
                if (pn < 4) {
#pragma unroll
                    for (int bj = 0; bj < 2; ++bj) { const int c = 256 * pn + cl0 + 32 * bj, g = c >> 4, c0 = c & 15;
                        if (row < MPR) { const int b = row >> 12, t = row & 4095; *(GAS u32x4*)(U + ((size_t)((g * 4 + b) * SEQ + t)) * 16 + c0) = pack8(v[bj][0], v[bj][1]); }
                        else { float* d = US + (size_t)(row - MPR) * DM + c; *(GAS f32x4*)d = v[bj][0]; *(GAS f32x4*)(d + 4) = v[bj][1]; } }
                } else if (pn < 10) {
                    const bool isq = pn < 7; const int grp = isq ? pn - 4 : pn - 7;
                    float sq = 0.f;
#pragma unroll
                    for (int bj = 0; bj < 2; ++bj)
#pragma unroll
                        for (int n = 0; n < 2; ++n) sq += (v[bj][n][0] * v[bj][n][0] + v[bj][n][1] * v[bj][n][1]) + (v[bj][n][2] * v[bj][n][2] + v[bj][n][3] * v[bj][n][3]);
                    sq += __shfl_xor(sq, 16); sq += __shfl_xor(sq, 32);
                    const float r = rsq(sq * (1.0f / HD) + RMS_EPS);
                    float* kd = isq ? nullptr : kvdst(grp, row, 0);
#pragma unroll
                    for (int bj = 0; bj < 2; ++bj) { const int d0 = 32 * bj + 8 * fq;
                        const f32x4 o0 = v[bj][0] * r * gn[bj][0], o1 = v[bj][1] * r * gn[bj][1];
                        *(GAS u32x4*)((isq ? Q : K) + qkv_off(grp, wc, row) + d0) = pack8(o0, o1);
                        if (kd) { *(GAS f32x4*)(kd + wc * 64 + d0) = o0; *(GAS f32x4*)(kd + wc * 64 + d0 + 4) = o1; } }
                } else if (pn < 13) {
                    const int grp = pn - 10; float* vd = kvdst(grp, row, 1);
#pragma unroll
                    for (int bj = 0; bj < 2; ++bj) { const int d0 = 32 * bj + 8 * fq;
                        *(GAS u32x4*)(V + qkv_off(grp, wc, row) + d0) = pack8(v[bj][0], v[bj][1]);
                        if (vd) { *(GAS f32x4*)(vd + wc * 64 + d0) = v[bj][0]; *(GAS f32x4*)(vd + wc * 64 + d0 + 4) = v[bj][1]; } }
                } else {
                    bf16* G = pn < 17 ? GA : GB; const int cb = 256 * (pn < 17 ? pn - 13 : pn - 17);
#pragma unroll
                    for (int bj = 0; bj < 2; ++bj) { f32x4 s0, s1;
#pragma unroll
                        for (int i = 0; i < 4; ++i) { s0[i] = sigmoidf_(v[bj][0][i]); s1[i] = sigmoidf_(v[bj][1][i]); }
                        *(GAS u32x4*)(G + (size_t)row * DM + cb + cl0 + 32 * bj) = pack8(s0, s1); }
                } }
    }
};
struct EpiState {
    float* SST;
    template <int AI_N = 2, int M_N = 4> __device__ __forceinline__ void run(const AccT& acc, const ge::Seg& u, int wr, int wc, int fr, int fq) const {
        const int r0 = u.pm * 256 + wr * 64 + fr;
#pragma unroll
        for (int ai = 0; ai < AI_N; ++ai)
#pragma unroll
            for (int m = 0; m < M_N; ++m) { float* d = SST + ((size_t)u.aux * 512 + r0 + ai * 128 + m * 16) * 128 + wc * 32 + 8 * fq;
                *(GAS f32x4*)d = acc[ai][0][m][0]; *(GAS f32x4*)(d + 4) = acc[ai][0][m][1]; }
    }
};
struct EpiStateLds {
    template <int AI_N = 2, int M_N = 4> __device__ __forceinline__ void run(const AccT&, const ge::Seg&, int, int, int, int) const {}
    __device__ __forceinline__ void drain(const AccT& acc, const ge::Seg&, int wr, int wc, int fr, int fq, LAS unsigned char* lds) const {
#pragma unroll
        for (int ai = 0; ai < 2; ++ai)
#pragma unroll
            for (int m = 0; m < 4; ++m) { const int row = ai * 128 + wr * 64 + m * 16 + fr, sl = (wc * 32 + 8 * fq) ^ (8 * fr);
                LAS float* d = (LAS float*)lds + row * 128 + sl; *(LAS f32x4*)d = acc[ai][0][m][0]; *(LAS f32x4*)(d + 4) = acc[ai][0][m][1]; }
    }
};
struct EpiSsmY {
    bf16* YS;
    template <int AI_N = 2, int M_N = 4> __device__ __forceinline__ void run(const AccT& acc, const ge::Seg& u, int wr, int wc, int fr, int fq) const {
        const int g = u.aux, r0 = u.pm * 256 + wr * 64 + fr;
#pragma unroll
        for (int ai = 0; ai < AI_N; ++ai)
#pragma unroll
            for (int m = 0; m < M_N; ++m) { const int r = r0 + ai * 128 + m * 16, b = r >> 7, chunk = r & 127;
#pragma unroll
                for (int bj = 0; bj < 2; ++bj) { const int slot = 128 * bj + 32 * wc + 8 * fq, tp = 16 * u.pn + (slot >> 4), co0 = slot & 15;
                    f32x4 y0 = acc[ai][bj][m][0], y1 = acc[ai][bj][m][1];
#pragma unroll
                    for (int i = 0; i < 4; ++i) { y0[i] = gelu_tanh(y0[i]); y1[i] = gelu_tanh(y1[i]); }
                    const size_t tok = (size_t)b * SEQ + chunk * CH + tp;
                    *(GAS u32x4*)(YS + tok * DM + g * 16 + co0) = pack8(y0, y1); } }
    }
};
template <int MODE> struct EpiElem {
    const bf16* P; const bf16* Q2; bf16* O;
    template <int AI_N = 2, int M_N = 4> __device__ __forceinline__ void run(const AccT& acc, const ge::Seg& u, int wr, int wc, int fr, int fq) const {
        const int row0 = u.pm * 256 + wr * 64 + fr, col0 = u.pn * 256 + wc * 32 + 8 * fq;
#pragma unroll
        for (int ai = 0; ai < AI_N; ++ai) {
            u32x4 pw[M_N][2], qw[M_N][2];
#pragma unroll
            for (int m = 0; m < M_N; ++m)
#pragma unroll
                for (int bj = 0; bj < 2; ++bj) if ((u.bjmask >> bj) & 1) { const size_t off = (size_t)(row0 + ai * 128 + m * 16) * DM + col0 + bj * 128;
                    pw[m][bj] = *(const GAS u32x4*)(P + off); if (MODE == 2) qw[m][bj] = *(const GAS u32x4*)(Q2 + off); }
#pragma unroll
            for (int m = 0; m < M_N; ++m)
#pragma unroll
                for (int bj = 0; bj < 2; ++bj) if ((u.bjmask >> bj) & 1) { const size_t off = (size_t)(row0 + ai * 128 + m * 16) * DM + col0 + bj * 128;
                    f32x4 p0, p1; unpack8(pw[m][bj], p0, p1);
                    f32x4 o0, o1; const f32x4 a0 = acc[ai][bj][m][0], a1 = acc[ai][bj][m][1];
                    if (MODE == 0) {
#pragma unroll
                        for (int i = 0; i < 4; ++i) { o0[i] = p0[i] * sigmoidf_(a0[i]); o1[i] = p1[i] * sigmoidf_(a1[i]); }
                    } else if (MODE == 1) { o0 = p0 * a0; o1 = p1 * a1; }
                    else { f32x4 q0, q1; unpack8(qw[m][bj], q0, q1); o0 = p0 * a0 + q0; o1 = p1 * a1 + q1; }
                    *(GAS u32x4*)(O + off) = pack8(o0, o1); }
        }
    }
};

template <class Epi>
__device__ __forceinline__ void skinny_unit(LAS unsigned char* lds, const bf16* A, int lda, const bf16* Bt, int ldb, int K, const Epi& E, int pn, int wc, int bjmask) {
    const int tid = threadIdx.x, w = __builtin_amdgcn_readfirstlane(tid >> 6), lane = tid & 63, fr = lane & 15, fq = lane >> 4;
    const int kw = K / 8, k00 = w * kw;
    f32x4 acc[2][2][2];
#pragma unroll
    for (int b = 0; b < 2; ++b)
#pragma unroll
        for (int m = 0; m < 2; ++m)
#pragma unroll
            for (int n = 0; n < 2; ++n) acc[b][m][n] = (f32x4){0.f, 0.f, 0.f, 0.f};
    const bf16* Ar = A + (size_t)(MPR + fr) * lda + k00 + 8 * fq;
    const bf16* Br = Bt + (size_t)(pn * 256 + 32 * wc + 8 * (fr >> 2) + (fr & 3)) * ldb + k00 + 8 * fq;
#define SK_STEP(ks_) do { const int ks = (ks_); bf16x8 a[2]; \
        _Pragma("unroll") for (int m = 0; m < 2; ++m) a[m] = *(const GAS bf16x8*)(Ar + (size_t)(16 * m) * lda + ks); \
        _Pragma("unroll") for (int b = 0; b < 2; ++b) if ((bjmask >> b) & 1) { \
            _Pragma("unroll") for (int n = 0; n < 2; ++n) { const bf16x8 bf = *(const GAS bf16x8*)(Br + (size_t)(128 * b + 4 * n) * ldb + ks); \
                _Pragma("unroll") for (int m = 0; m < 2; ++m) acc[b][m][n] = __builtin_amdgcn_mfma_f32_16x16x32_bf16(bf, a[m], acc[b][m][n], 0, 0, 0); } } } while (0)
    {
        int k1 = 0;
        for (; k1 + 192 <= kw; k1 += 192) {
#pragma unroll
            for (int u = 0; u < 6; ++u) SK_STEP(k1 + 32 * u); }
        for (; k1 + 160 <= kw; k1 += 160) {
#pragma unroll
            for (int u = 0; u < 5; ++u) SK_STEP(k1 + 32 * u); }
        for (; k1 + 128 <= kw; k1 += 128) {
#pragma unroll
            for (int u = 0; u < 4; ++u) SK_STEP(k1 + 32 * u); }
        for (; k1 < kw; k1 += 32) SK_STEP(k1);
    }
#undef SK_STEP
    LAS f32x4* T = (LAS f32x4*)lds;
#define SK_WR(slot) do { _Pragma("unroll") for (int b = 0; b < 2; ++b) _Pragma("unroll") for (int m = 0; m < 2; ++m) _Pragma("unroll") for (int n = 0; n < 2; ++n) T[(slot) * 512 + (((b * 2 + m) * 2 + n) * 64) + lane] = acc[b][m][n]; } while (0)
#define SK_ADD(slot) do { _Pragma("unroll") for (int b = 0; b < 2; ++b) _Pragma("unroll") for (int m = 0; m < 2; ++m) _Pragma("unroll") for (int n = 0; n < 2; ++n) acc[b][m][n] = acc[b][m][n] + T[(slot) * 512 + (((b * 2 + m) * 2 + n) * 64) + lane]; } while (0)
    if (w >= 4) SK_WR(w - 4);
    __syncthreads();
    if (w < 4) SK_ADD(w);
    if (w == 2 || w == 3) SK_WR(4 + (w - 2));
    __syncthreads();
    if (w < 2) SK_ADD(4 + w);
    if (w == 1) SK_WR(6);
    __syncthreads();
    if (w == 0) {
        SK_ADD(6);
        AccT o;
#pragma unroll
        for (int b = 0; b < 2; ++b)
#pragma unroll
            for (int m = 0; m < 2; ++m)
#pragma unroll
                for (int n = 0; n < 2; ++n) o[0][b][m][n] = acc[b][m][n];
        ge::Seg u; u.A = nullptr; u.B = nullptr; u.nt = 0; u.flags = 1; u.geo = 0; u.pm = MPR / 256; u.pn = pn; u.aux = 0; u.bjmask = bjmask;
        E.template run<1, 2>(o, u, 0, wc, fr, fq);
    }
#undef SK_WR
#undef SK_ADD
    __syncthreads();
}
__device__ __forceinline__ void skinny_merge_unit(LAS unsigned char* lds, const bf16* YA, const bf16* WPA, const bf16* OB, const bf16* WPB, const bf16* GA, const bf16* GB, bf16* OUT, int pn, int wc, int bjs) {
    const int tid = threadIdx.x, w = __builtin_amdgcn_readfirstlane(tid >> 6), lane = tid & 63, fr = lane & 15, fq = lane >> 4;
    f32x4 acc[2][2][2];
#pragma unroll
    for (int b = 0; b < 2; ++b)
#pragma unroll
        for (int m = 0; m < 2; ++m)
#pragma unroll
            for (int n = 0; n < 2; ++n) acc[b][m][n] = (f32x4){0.f, 0.f, 0.f, 0.f};
    const int srow = pn * 256 + 128 * bjs + 32 * wc + 8 * (fr >> 2) + (fr & 3);
    {   const int k00 = w * (DM / 8);
        const bf16* Ar = YA + (size_t)(MPR + fr) * DM + k00 + 8 * fq; const bf16* Br = WPA + (size_t)srow * DM + k00 + 8 * fq;
        const bf16* A2 = OB + (size_t)(MPR + fr) * SW + w * (SW / 8) + 8 * fq; const bf16* B2 = WPB + (size_t)srow * SW + w * (SW / 8) + 8 * fq;
        bf16x8 a[4][2], bfr[4][2], a2[2], b2[2];
#pragma unroll
        for (int ks = 0; ks < 4; ++ks)
#pragma unroll
            for (int m = 0; m < 2; ++m) { a[ks][m] = *(const GAS bf16x8*)(Ar + (size_t)(16 * m) * DM + 32 * ks); bfr[ks][m] = *(const GAS bf16x8*)(Br + (size_t)(4 * m) * DM + 32 * ks); }
#pragma unroll
        for (int m = 0; m < 2; ++m) { a2[m] = *(const GAS bf16x8*)(A2 + (size_t)(16 * m) * SW); b2[m] = *(const GAS bf16x8*)(B2 + (size_t)(4 * m) * SW); }
#pragma unroll
        for (int ks = 0; ks < 4; ++ks)
#pragma unroll
            for (int n = 0; n < 2; ++n)
#pragma unroll
                for (int m = 0; m < 2; ++m) acc[0][m][n] = __builtin_amdgcn_mfma_f32_16x16x32_bf16(bfr[ks][n], a[ks][m], acc[0][m][n], 0, 0, 0);
#pragma unroll
        for (int n = 0; n < 2; ++n)
#pragma unroll
            for (int m = 0; m < 2; ++m) acc[1][m][n] = __builtin_amdgcn_mfma_f32_16x16x32_bf16(b2[n], a2[m], acc[1][m][n], 0, 0, 0);
    }
    LAS f32x4* T = (LAS f32x4*)lds;
#define SK_WR(slot) do { _Pragma("unroll") for (int b = 0; b < 2; ++b) _Pragma("unroll") for (int m = 0; m < 2; ++m) _Pragma("unroll") for (int n = 0; n < 2; ++n) T[(slot) * 512 + (((b * 2 + m) * 2 + n) * 64) + lane] = acc[b][m][n]; } while (0)
#define SK_ADD(slot) do { _Pragma("unroll") for (int b = 0; b < 2; ++b) _Pragma("unroll") for (int m = 0; m < 2; ++m) _Pragma("unroll") for (int n = 0; n < 2; ++n) acc[b][m][n] = acc[b][m][n] + T[(slot) * 512 + (((b * 2 + m) * 2 + n) * 64) + lane]; } while (0)
    if (w >= 4) SK_WR(w - 4);
    __syncthreads();
    if (w < 4) SK_ADD(w);
    if (w == 2 || w == 3) SK_WR(4 + (w - 2));
    __syncthreads();
    if (w < 2) SK_ADD(4 + w);
    if (w == 1) SK_WR(6);
    __syncthreads();
    if (w == 0) {
        SK_ADD(6);
#pragma unroll
        for (int m = 0; m < 2; ++m) { const size_t off = (size_t)(MPR + 16 * m + fr) * DM + pn * 256 + 128 * bjs + 32 * wc + 8 * fq;
            f32x4 ga0, ga1, gb0, gb1; unpack8(*(const GAS u32x4*)(GA + off), ga0, ga1); unpack8(*(const GAS u32x4*)(GB + off), gb0, gb1);
            *(GAS u32x4*)(OUT + off) = pack8(ga0 * acc[0][m][0] + gb0 * acc[1][m][0], ga1 * acc[0][m][1] + gb1 * acc[1][m][1]); }
    }
#undef SK_WR
#undef SK_ADD
    __syncthreads();
}
template <bool SPLIT, class Epi>
__device__ __forceinline__ void skinny_phase(Frame& F, const void* A, int lda, const void* Bt, int ldb, int N, int K, const Epi& E) {
    const int nS = SPLIT ? N / 32 : N / 64;
    for (int j = F.G - 1 - F.bid; j < nS; j += F.G) {
        if (SPLIT) skinny_unit(F.lds, (const bf16*)A, lda, (const bf16*)Bt, ldb, K, E, j >> 3, (j >> 1) & 3, 1 << (j & 1));
        else skinny_unit(F.lds, (const bf16*)A, lda, (const bf16*)Bt, ldb, K, E, j >> 2, j & 3, 3); }
}

struct StateSched {
    const char* U; const char* W1T; int G, c;
    __device__ __forceinline__ bool seg(int i, ge::Seg& s) const {
        const int un = i * G + c; if (un >= 128) return false;
        const int g = un >> 1, pm = un & 1;
        s.A = U + ((size_t)g * 512 + 256 * pm) * 1024; s.B = W1T + (size_t)g * 128 * 1024; s.nt = 8; s.flags = 1; s.geo = 0; s.pm = pm; s.pn = 0; s.aux = g; s.bjmask = 3; return true;
    }
};
struct SsmYSched {
    const char* HS; const char* BH; const char* U; const char* KT; int G, c;
    __device__ __forceinline__ bool seg(int i, ge::Seg& s) const {
        const int un = (i >> 1) * G + c; if (un >= 256) return false;
        const int g = un >> 2, pm = (un >> 1) & 1, pn = un & 1;
        s.pm = pm; s.pn = pn; s.aux = g; s.bjmask = 3;
        if ((i & 1) == 0) { s.A = HS + ((size_t)g * 512 + 256 * pm) * 256; s.B = BH + ((size_t)g * 512 + 256 * pn) * 256; s.nt = 2; s.flags = 0; s.geo = 0; }
        else { s.A = U + ((size_t)g * 512 + 256 * pm) * 1024; s.B = KT + (size_t)g * KT_STRIDE + (size_t)(16 * pn) * 512; s.nt = 4 * (pn + 1); s.flags = 1; s.geo = 1; }
        return true;
    }
};

struct SsmYSchedB {
    const char* HS; const char* BH; const char* U; const char* KT; int c;
    __device__ __forceinline__ bool seg(int i, ge::Seg& s) const {
        if (i >= 4) return false;
        const int g = c >> 1, pm = c & 1, pn = i >> 1;
        s.pm = pm; s.pn = pn; s.aux = g; s.bjmask = 3;
        if ((i & 1) == 0) { s.A = HS + ((size_t)g * 512 + 256 * pm) * 256; s.B = BH + ((size_t)g * 512 + 256 * pn) * 256; s.nt = 2; s.flags = 0; s.geo = 0; }
        else { s.A = U + ((size_t)g * 512 + 256 * pm) * 1024; s.B = KT + (size_t)g * KT_STRIDE + (size_t)(16 * pn) * 512; s.nt = 4 * (pn + 1); s.flags = 1; s.geo = 1; }
        return true;
    }
};

constexpr int ATT_RB = 144;
constexpr int ATT_K = 0, ATT_V = 384 * ATT_RB;
constexpr float LOG2E = 1.4426950408889634f, LN2 = 0.6931471805599453f;
__device__ __forceinline__ float alibi_slope(int g, int hc) { return exp2f(-8.0f * (float)(4 * g + hc + 1) / 12.0f); }
__device__ __forceinline__ void attn_item(Frame& F, int it) {
    const int g = it >> 8, rem = it & 255, b = rem >> 6, hc = (rem >> 4) & 3, idx = rem & 15;
    const int dsh = 2 * g, d = 1 << dsh, r = idx & (d - 1), qb = idx >> dsh, i0 = qb * 256;
    const size_t hb = ((size_t)(g * 4 + hc) * MP + (size_t)b * SEQ + (size_t)r * (SEQ >> dsh)) * 64;
    const bf16* Qg = (const bf16*)(F.ws + WS_Q) + hb;
    const bf16* Kg = (const bf16*)(F.ws + WS_K) + hb;
    const bf16* Vg = (const bf16*)(F.ws + WS_V) + hb;
    LAS unsigned char* lds = F.lds;
    const int w = F.wave, lane = F.lane, ql = lane & 31, h = lane >> 5;
    const size_t tokq = (size_t)b * SEQ + (size_t)(i0 + 32 * w + ql) * d + r;
    bf16x8 qf[4];
#pragma unroll
    for (int s = 0; s < 4; ++s) qf[s] = *(const GAS bf16x8*)(Qg + (size_t)(i0 + 32 * w + ql) * 64 + 16 * s + 8 * h);
    {
        const int piece = F.tid & 7;
#pragma unroll
        for (int pass = 0; pass < 6; ++pass) { const int rho = pass * 64 + (F.tid >> 3), i = i0 - 128 + rho;
            u32x4 kv = (u32x4){0u, 0u, 0u, 0u}, vv = kv;
            if (i >= 0) { kv = *(const GAS u32x4*)(Kg + (size_t)i * 64 + piece * 8); vv = *(const GAS u32x4*)(Vg + (size_t)i * 64 + piece * 8); }
            *(LAS u32x4*)(lds + ATT_K + rho * ATT_RB + piece * 16) = kv; *(LAS u32x4*)(lds + ATT_V + rho * ATT_RB + piece * 16) = vv; }
    }
    __syncthreads();
    f32x16 st[5];
#pragma unroll
    for (int j = 0; j < 5; ++j) { st[j] = (f32x16){0.f, 0.f, 0.f, 0.f, 0.f, 0.f, 0.f, 0.f, 0.f, 0.f, 0.f, 0.f, 0.f, 0.f, 0.f, 0.f};
#pragma unroll
        for (int s = 0; s < 4; ++s) { const bf16x8 kf = *(const LAS bf16x8*)(lds + ATT_K + (32 * w + 32 * j + ql) * ATT_RB + (16 * s + 8 * h) * 2);
            st[j] = __builtin_amdgcn_mfma_f32_32x32x16_bf16(kf, qf[s], st[j], 0, 0, 0); } }
    const float sl2 = alibi_slope(g, hc) * (float)d * LOG2E;
    float mx = -3.0e38f;
#pragma unroll
    for (int j = 0; j < 5; ++j)
#pragma unroll
        for (int rg = 0; rg < 16; ++rg) { const int kvl = (rg & 3) + 8 * (rg >> 2) + 4 * h, delta = 128 + ql - 32 * j - kvl, ikv = i0 - 128 + 32 * w + 32 * j + kvl;
            const bool ok = (delta >= 0) && (delta <= 128) && (ikv >= 0);
            const float s2 = ok ? (st[j][rg] * LOG2E - sl2 * (float)delta) : -3.0e38f;
            st[j][rg] = s2; mx = fmaxf(mx, s2); }
    mx = fmaxf(mx, __shfl_xor(mx, 32));
    float den = 0.f;
#pragma unroll
    for (int j = 0; j < 5; ++j)
#pragma unroll
        for (int rg = 0; rg < 16; ++rg) { const float p = fast_exp2(st[j][rg] - mx); st[j][rg] = p; den += p; }
    den += __shfl_xor(den, 32);
    const float inv = 1.0f / den;
    if (h == 0) ((float*)(F.ws + WS_LSE))[((size_t)g * MPR + tokq) * 4 + hc] = (mx + __log2f(den)) * LN2;
    const int qq = (lane & 15) >> 2, pp = lane & 3, gsel = (lane >> 4) & 1;
    f32x16 o[2];
#pragma unroll
    for (int db = 0; db < 2; ++db) { o[db] = (f32x16){0.f, 0.f, 0.f, 0.f, 0.f, 0.f, 0.f, 0.f, 0.f, 0.f, 0.f, 0.f, 0.f, 0.f, 0.f, 0.f}; }
#pragma unroll
    for (int j = 0; j < 5; ++j)
#pragma unroll
        for (int sp = 0; sp < 2; ++sp) {
            u32x4 pw; pw.x = cvt_pk_bf16(st[j][8 * sp + 0] * inv, st[j][8 * sp + 1] * inv); pw.y = cvt_pk_bf16(st[j][8 * sp + 2] * inv, st[j][8 * sp + 3] * inv);
            pw.z = cvt_pk_bf16(st[j][8 * sp + 4] * inv, st[j][8 * sp + 5] * inv); pw.w = cvt_pk_bf16(st[j][8 * sp + 6] * inv, st[j][8 * sp + 7] * inv);
            const bf16x8 pa = __builtin_bit_cast(bf16x8, pw);
#pragma unroll
            for (int db = 0; db < 2; ++db) {
                LAS unsigned char* vp = lds + ATT_V + (32 * w + 32 * j + 16 * sp + 4 * h + qq) * ATT_RB + (32 * db + 16 * gsel + 4 * pp) * 2;
                const s16x4 lo = __builtin_bit_cast(s16x4, __builtin_amdgcn_ds_read_tr16_b64_v4i16((LAS s16x4*)vp));
                const s16x4 hi = __builtin_bit_cast(s16x4, __builtin_amdgcn_ds_read_tr16_b64_v4i16((LAS s16x4*)(vp + 8 * ATT_RB)));
                const bf16x8 vb = (bf16x8){lo[0], lo[1], lo[2], lo[3], hi[0], hi[1], hi[2], hi[3]};
                o[db] = __builtin_amdgcn_mfma_f32_32x32x16_bf16(pa, vb, o[db], 0, 0, 0); } }
    const int odd = lane & 1;
    bf16* OG = (bf16*)(F.ws + WS_OG) + (size_t)g * MPR * SW + hc * 64 + ((lane & 31) - odd) + 32 * odd;
#pragma unroll
    for (int rg = 0; rg < 16; ++rg) { const int qrow = (rg & 3) + 8 * (rg >> 2) + 4 * h; const size_t tok = (size_t)b * SEQ + (size_t)(i0 + 32 * w + qrow) * d + r;
        const float p0 = __shfl_xor(o[0][rg], 1), p1 = __shfl_xor(o[1][rg], 1);
        *(GAS unsigned*)(OG + tok * SW) = odd ? cvt_pk_bf16(p1, o[1][rg]) : cvt_pk_bf16(o[0][rg], p0); }
    __syncthreads();
}
struct AttPre { u32x4 k[6]; bf16x8 q[4]; };
__device__ __forceinline__ void attn_pre_load(Frame& F, int it, AttPre& P) {
    const int g = it >> 8, rem = it & 255, b = rem >> 6, hc = (rem >> 4) & 3, idx = rem & 15;
    const int dsh = 2 * g, d = 1 << dsh, r = idx & (d - 1), qb = idx >> dsh, i0 = qb * 256;
    const size_t hb = ((size_t)(g * 4 + hc) * MP + (size_t)b * SEQ + (size_t)r * (SEQ >> dsh)) * 64;
    const bf16* Kg = (const bf16*)(F.ws + WS_K) + hb;
    const int piece = F.tid & 7;
    { const bf16* Qg = (const bf16*)(F.ws + WS_Q) + hb; const int ql = F.lane & 31, h = F.lane >> 5;
#pragma unroll
      for (int s = 0; s < 4; ++s) P.q[s] = *(const GAS bf16x8*)(Qg + (size_t)(i0 + 32 * F.wave + ql) * 64 + 16 * s + 8 * h); }
#pragma unroll
    for (int pass = 0; pass < 6; ++pass) { const int rho = pass * 64 + (F.tid >> 3), i = i0 - 128 + rho;
        u32x4 kv = (u32x4){0u, 0u, 0u, 0u};
        if (i >= 0) kv = *(const GAS u32x4*)(Kg + (size_t)i * 64 + piece * 8);
        P.k[pass] = kv; }
}
__device__ __forceinline__ int attn_item_pipe(Frame& F, int it, unsigned* ctr, volatile LAS int* nxw, AttPre& P) {
    const int g = it >> 8, rem = it & 255, b = rem >> 6, hc = (rem >> 4) & 3, idx = rem & 15;
    const int dsh = 2 * g, d = 1 << dsh, r = idx & (d - 1), qb = idx >> dsh, i0 = qb * 256;
    const bf16* Vg = (const bf16*)(F.ws + WS_V) + ((size_t)(g * 4 + hc) * MP + (size_t)b * SEQ + (size_t)r * (SEQ >> dsh)) * 64;
    LAS unsigned char* lds = F.lds;
    unsigned nx_ = 0u; if (F.tid == 0) nx_ = xb_add(ctr, 1u);
    int lane_ = F.lane; asm volatile("" : "+v"(lane_));
    const int w = F.wave, lane = lane_, ql = lane & 31, h = lane >> 5, piece = F.tid & 7;
    const size_t tokq = (size_t)b * SEQ + (size_t)(i0 + 32 * w + ql) * d + r;
    u32x4 vv[6];
#pragma unroll
    for (int pass = 0; pass < 6; ++pass) { const int rho = pass * 64 + (F.tid >> 3), i = i0 - 128 + rho;
        u32x4 x = (u32x4){0u, 0u, 0u, 0u};
        if (i >= 0) x = *(const GAS u32x4*)(Vg + (size_t)i * 64 + piece * 8);
        vv[pass] = x; }
    bf16x8 qf[4];
#pragma unroll
    for (int s = 0; s < 4; ++s) qf[s] = P.q[s];
#pragma unroll
    for (int pass = 0; pass < 6; ++pass) *(LAS u32x4*)(lds + ATT_K + (pass * 64 + (F.tid >> 3)) * ATT_RB + piece * 16) = P.k[pass];
    __syncthreads();
    f32x16 st[5];
#pragma unroll
    for (int j = 0; j < 5; ++j) { st[j] = (f32x16){0.f, 0.f, 0.f, 0.f, 0.f, 0.f, 0.f, 0.f, 0.f, 0.f, 0.f, 0.f, 0.f, 0.f, 0.f, 0.f};
#pragma unroll
        for (int s = 0; s < 4; ++s) { const bf16x8 kf = *(const LAS bf16x8*)(lds + ATT_K + (32 * w + 32 * j + ql) * ATT_RB + (16 * s + 8 * h) * 2);
            st[j] = __builtin_amdgcn_mfma_f32_32x32x16_bf16(kf, qf[s], st[j], 0, 0, 0); } }
    const float sl2 = alibi_slope(g, hc) * (float)d * LOG2E;
    float mx = -3.0e38f;
#pragma unroll
    for (int j = 0; j < 5; ++j)
#pragma unroll
        for (int rg = 0; rg < 16; ++rg) { const int kvl = (rg & 3) + 8 * (rg >> 2) + 4 * h, delta = 128 + ql - 32 * j - kvl, ikv = i0 - 128 + 32 * w + 32 * j + kvl;
            const bool ok = (delta >= 0) && (delta <= 128) && (ikv >= 0);
            const float s2 = ok ? (st[j][rg] * LOG2E - sl2 * (float)delta) : -3.0e38f;
            st[j][rg] = s2; mx = fmaxf(mx, s2); }
    mx = fmaxf(mx, __shfl_xor(mx, 32));
    float den = 0.f;
#pragma unroll
    for (int j = 0; j < 5; ++j)
#pragma unroll
        for (int rg = 0; rg < 16; ++rg) { const float p = fast_exp2(st[j][rg] - mx); st[j][rg] = p; den += p; }
    den += __shfl_xor(den, 32);
    const float inv = 1.0f / den;
    if (h == 0) ((float*)(F.ws + WS_LSE))[((size_t)g * MPR + tokq) * 4 + hc] = (mx + __log2f(den)) * LN2;
    u32x4 pk[5][2];
#pragma unroll
    for (int j = 0; j < 5; ++j)
#pragma unroll
        for (int sp = 0; sp < 2; ++sp) {
            pk[j][sp].x = cvt_pk_bf16(st[j][8 * sp + 0] * inv, st[j][8 * sp + 1] * inv); pk[j][sp].y = cvt_pk_bf16(st[j][8 * sp + 2] * inv, st[j][8 * sp + 3] * inv);
            pk[j][sp].z = cvt_pk_bf16(st[j][8 * sp + 4] * inv, st[j][8 * sp + 5] * inv); pk[j][sp].w = cvt_pk_bf16(st[j][8 * sp + 6] * inv, st[j][8 * sp + 7] * inv); }
#pragma unroll
    for (int pass = 0; pass < 6; ++pass) *(LAS u32x4*)(lds + ATT_V + (pass * 64 + (F.tid >> 3)) * ATT_RB + piece * 16) = vv[pass];
    if (F.tid == 0) *nxw = 16 + (int)nx_;
    __syncthreads();
    const int nseq = __builtin_amdgcn_readfirstlane(*nxw); const int next_it = nseq < 96 ? 8 * nseq + (F.bid & 7) : 768 + (nseq - 96);
    if (next_it < 768) attn_pre_load(F, next_it, P);
    const int qq = (lane & 15) >> 2, pp = lane & 3, gsel = (lane >> 4) & 1;
    f32x16 o[2];
#pragma unroll
    for (int db = 0; db < 2; ++db) { o[db] = (f32x16){0.f, 0.f, 0.f, 0.f, 0.f, 0.f, 0.f, 0.f, 0.f, 0.f, 0.f, 0.f, 0.f, 0.f, 0.f, 0.f}; }
#pragma unroll
    for (int j = 0; j < 5; ++j)
#pragma unroll
        for (int sp = 0; sp < 2; ++sp) {
            const bf16x8 pa = __builtin_bit_cast(bf16x8, pk[j][sp]);
#pragma unroll
            for (int db = 0; db < 2; ++db) {
                LAS unsigned char* vp = lds + ATT_V + (32 * w + 32 * j + 16 * sp + 4 * h + qq) * ATT_RB + (32 * db + 16 * gsel + 4 * pp) * 2;
                const s16x4 lo = __builtin_bit_cast(s16x4, __builtin_amdgcn_ds_read_tr16_b64_v4i16((LAS s16x4*)vp));
                const s16x4 hi = __builtin_bit_cast(s16x4, __builtin_amdgcn_ds_read_tr16_b64_v4i16((LAS s16x4*)(vp + 8 * ATT_RB)));
                const bf16x8 vb = (bf16x8){lo[0], lo[1], lo[2], lo[3], hi[0], hi[1], hi[2], hi[3]};
                o[db] = __builtin_amdgcn_mfma_f32_32x32x16_bf16(pa, vb, o[db], 0, 0, 0); } }
    const int odd = lane & 1;
    bf16* OG = (bf16*)(F.ws + WS_OG) + (size_t)g * MPR * SW + hc * 64 + ((lane & 31) - odd) + 32 * odd;
#pragma unroll
    for (int rg = 0; rg < 16; ++rg) { const int qrow = (rg & 3) + 8 * (rg >> 2) + 4 * h; const size_t tok = (size_t)b * SEQ + (size_t)(i0 + 32 * w + qrow) * d + r;
        const float p0 = __shfl_xor(o[0][rg], 1), p1 = __shfl_xor(o[1][rg], 1);
        *(GAS unsigned*)(OG + tok * SW) = odd ? cvt_pk_bf16(p1, o[1][rg]) : cvt_pk_bf16(o[0][rg], p0); }
    return next_it;
}
constexpr size_t WS_SOG = WS_US + 128 * 1024, WS_SLSE = WS_US + 256 * 1024;
__device__ __forceinline__ void attn_sample_task(Frame& F, int task, int scr) {
    const int g = task % 3, sh = task / 3, sb = sh >> 2, hc = sh & 3, lane = F.lane;
    LAS float* ps = (LAS float*)(F.lds + scr);
    const int W = 128 << (2 * g), d = 1 << (2 * g);
    const float* cache = FIN(4 + g) + (size_t)sb * W * 512;
    const float* newkv = F.out + (g == 0 ? O_SKV0 : g == 1 ? O_SKV1 : O_SKV2) + ((size_t)(sb * W + W - 1) * 2) * 256;
    const bf16* Qs = (const bf16*)(F.ws + WS_Q) + qkv_off(g, hc, MPR + sb);
    const float slope = alibi_slope(g, hc);
    float s0, s1, s2;
    {   u32x4 qw[8]; f32x4 k0[16], k1[16];
        const float* kr0 = (lane == 0) ? newkv + hc * 64 : cache + (size_t)(W - lane * d) * 512 + hc * 64;
        const float* kr1 = cache + (size_t)(W - (lane + 64) * d) * 512 + hc * 64;
#pragma unroll
        for (int c = 0; c < 8; ++c) qw[c] = *(const GAS u32x4*)(Qs + 8 * c);
#pragma unroll
        for (int c = 0; c < 16; ++c) { k0[c] = *(const GAS f32x4*)(kr0 + 4 * c); k1[c] = *(const GAS f32x4*)(kr1 + 4 * c); }
        float d0 = 0.f, d1 = 0.f;
#pragma unroll
        for (int c = 0; c < 16; ++c) { const unsigned w0 = qw[c >> 1][(c & 1) * 2], w1 = qw[c >> 1][(c & 1) * 2 + 1];
            const float q0 = bflo(w0), q1 = bfhi(w0), q2 = bflo(w1), q3 = bfhi(w1);
            d0 += (k0[c][0] * q0 + k0[c][1] * q1) + (k0[c][2] * q2 + k0[c][3] * q3);
            d1 += (k1[c][0] * q0 + k1[c][1] * q1) + (k1[c][2] * q2 + k1[c][3] * q3); }
        s0 = d0 - slope * (float)(lane * d); s1 = d1 - slope * (float)((lane + 64) * d);
        const float* kr2 = cache + hc * 64;
        const int kg = lane >> 4, dc = lane & 15;
        f32x4 va[16];
#pragma unroll
        for (int c = 0; c < 16; ++c) k0[c] = *(const GAS f32x4*)(kr2 + 4 * c);
#pragma unroll
        for (int k = 0; k < 16; ++k) { const int j = 4 * k + kg; const float* vr = (j == 0) ? newkv + 256 + hc * 64 : cache + (size_t)(W - j * d) * 512 + 256 + hc * 64; va[k] = *(const GAS f32x4*)(vr + 4 * dc); }
        float d2 = 0.f;
#pragma unroll
        for (int c = 0; c < 16; ++c) { const unsigned w0 = qw[c >> 1][(c & 1) * 2], w1 = qw[c >> 1][(c & 1) * 2 + 1];
            d2 += (k0[c][0] * bflo(w0) + k0[c][1] * bfhi(w0)) + (k0[c][2] * bflo(w1) + k0[c][3] * bfhi(w1)); }
        s2 = (lane == 0) ? d2 - slope * (float)(128 * d) : -3.0e38f;
        const float m = wave_max(fmaxf(fmaxf(s0, s1), s2));
        const float p0 = __expf(s0 - m), p1 = __expf(s1 - m), p2 = __expf(s2 - m);
        const float den = wave_sum(p0 + p1 + p2);
        ps[lane] = p0; ps[64 + lane] = p1; ps[128 + lane] = p2;
        LDS_WAIT(); asm volatile("" ::: "memory");
        f32x4 vb[17];
#pragma unroll
        for (int k = 0; k < 17; ++k) { const int j = 4 * (16 + k) + kg; const int jj = j <= 128 ? j : 128; vb[k] = *(const GAS f32x4*)(cache + (size_t)(W - jj * d) * 512 + 256 + hc * 64 + 4 * dc); }
        f32x4 o = (f32x4){0.f, 0.f, 0.f, 0.f};
#pragma unroll
        for (int k = 0; k < 16; ++k) o += ps[4 * k + kg] * va[k];
#pragma unroll
        for (int k = 0; k < 17; ++k) { const int j = 4 * (16 + k) + kg; o += (j <= 128 ? ps[j] : 0.f) * vb[k]; }
#pragma unroll
        for (int c = 0; c < 4; ++c) { o[c] += __shfl_xor(o[c], 16); o[c] += __shfl_xor(o[c], 32); }
        LDS_WAIT(); asm volatile("" ::: "memory");
        if (lane < 16) *(GAS f32x4*)((float*)(F.ws + WS_SOG) + (size_t)(sh * 3 + g) * 64 + 4 * dc) = o * (1.0f / den);
        if (lane == 0) ((float*)(F.ws + WS_SLSE))[sh * 3 + g] = m + __logf(den);
    }
}
__device__ __forceinline__ void sample_mix(Frame& F) {
    const int gt = F.bid * (NWAVES * 64) + F.tid;
    if (gt < NSMP * 4 * 64) { const int sh = gt >> 6, dim = gt & 63, sb = sh >> 2, hc = sh & 3;
        const float lv = ((const float*)(F.ws + WS_SLSE))[sh * 3 + (F.lane % 3)];
        const float l0 = __shfl(lv, 0), l1 = __shfl(lv, 1), l2 = __shfl(lv, 2);
        const float mx = fmaxf(fmaxf(l0, l1), l2); const float w0 = __expf(l0 - mx), w1 = __expf(l1 - mx), w2 = __expf(l2 - mx);
        const float* og = (const float*)(F.ws + WS_SOG) + (size_t)sh * 3 * 64 + dim;
        const float ob = (w0 * og[0] + w1 * og[64] + w2 * og[128]) / (w0 + w1 + w2);
        ((bf16*)(F.ws + WS_OB))[(size_t)(MPR + sb) * SW + hc * 64 + dim] = (bf16)f2bf(ob); }
}

__device__ __forceinline__ void p5_combine(Frame& F) {
    const size_t gt = (size_t)F.bid * (NWAVES * 64) + F.tid, NT = (size_t)F.G * NWAVES * 64;
    const float* LSE = (const float*)(F.ws + WS_LSE); const GAS u32x2* OG = (const GAS u32x2*)(F.ws + WS_OG); bf16* OB = (bf16*)(F.ws + WS_OB);
    for (size_t e = gt; e < (size_t)MPR * 64; e += NT) { const size_t tok = e >> 6; const int hc = (int)(e >> 4) & 3;
        const float l0 = LSE[tok * 4 + hc], l1 = LSE[((size_t)MPR + tok) * 4 + hc], l2 = LSE[((size_t)2 * MPR + tok) * 4 + hc];
        const float mx = fmaxf(fmaxf(l0, l1), l2); const float w0 = __expf(l0 - mx), w1 = __expf(l1 - mx), w2 = __expf(l2 - mx); const float inv = 1.0f / (w0 + w1 + w2);
        const u32x2 aw = OG[e], bw = OG[(size_t)MPR * 64 + e], cw = OG[(size_t)2 * MPR * 64 + e];
        const f32x4 a = (f32x4){bflo(aw.x), bfhi(aw.x), bflo(aw.y), bfhi(aw.y)}, b = (f32x4){bflo(bw.x), bfhi(bw.x), bflo(bw.y), bfhi(bw.y)}, c = (f32x4){bflo(cw.x), bfhi(cw.x), bflo(cw.y), bfhi(cw.y)};
        const f32x4 o = (w0 * a + w1 * b + w2 * c) * inv;
        u32x2 pk; pk.x = cvt_pk_bf16(o[0], o[1]); pk.y = cvt_pk_bf16(o[2], o[3]);
        *(GAS u32x2*)(OB + e * 4) = pk; }
}
__device__ __forceinline__ void p5_carry(Frame& F, int g, int b) {
    const int p = F.lane;
    const float* sp = (const float*)(F.ws + WS_SSMP);
    const float ar = sp[SSMP_A32 / 4 + (g * 64 + p) * 2], ai = sp[SSMP_A32 / 4 + (g * 64 + p) * 2 + 1];
    const float* SST = (const float*)(F.ws + WS_SST) + ((size_t)g * 512 + b * 128) * 128; bf16* HS = (bf16*)(F.ws + WS_HS) + ((size_t)g * 512 + b * 128) * 128;
    float hr = 0.f, hi = 0.f;
    for (int cb = 0; cb < NCH; cb += 16) { float sr[16], si[16];
#pragma unroll
        for (int k = 0; k < 16; ++k) { sr[k] = SST[(size_t)(cb + k) * 128 + p]; si[k] = SST[(size_t)(cb + k) * 128 + 64 + p]; }
#pragma unroll
        for (int k = 0; k < 16; ++k) { HS[(size_t)(cb + k) * 128 + p] = (bf16)f2bf(hr); HS[(size_t)(cb + k) * 128 + 64 + p] = (bf16)f2bf(hi);
            const float nr = ar * hr - ai * hi + sr[k], ni = ar * hi + ai * hr + si[k]; hr = nr; hi = ni; } }
    F.out[O_PSR + (size_t)(b * 64 + g) * 64 + p] = hr; F.out[O_PSI + (size_t)(b * 64 + g) * 64 + p] = hi;
}
__device__ __forceinline__ void p5_carry_lds(Frame& F, int g, int b, int bl) {
    const int p = F.lane;
    const float* sp = (const float*)(F.ws + WS_SSMP);
    const float ar = sp[SSMP_A32 / 4 + (g * 64 + p) * 2], ai = sp[SSMP_A32 / 4 + (g * 64 + p) * 2 + 1];
    const LAS float* SL = (const LAS float*)F.lds + (size_t)bl * 128 * 128; bf16* HS = (bf16*)(F.ws + WS_HS) + ((size_t)g * 512 + b * 128) * 128;
    float hr = 0.f, hi = 0.f;
    for (int cb = 0; cb < NCH; cb += 16) { float sr[16], si[16];
#pragma unroll
        for (int k = 0; k < 16; ++k) { sr[k] = SL[(cb + k) * 128 + (p ^ (8 * k))]; si[k] = SL[(cb + k) * 128 + ((64 + p) ^ (8 * k))]; }
#pragma unroll
        for (int k = 0; k < 16; ++k) { HS[(size_t)(cb + k) * 128 + p] = (bf16)f2bf(hr); HS[(size_t)(cb + k) * 128 + 64 + p] = (bf16)f2bf(hi);
            const float nr = ar * hr - ai * hi + sr[k], ni = ar * hi + ai * hr + si[k]; hr = nr; hi = ni; } }
    F.out[O_PSR + (size_t)(b * 64 + g) * 64 + p] = hr; F.out[O_PSI + (size_t)(b * 64 + g) * 64 + p] = hi;
}
struct SsmLd { float ar, ai, h0r, h0i, uval, dsk; f32x4 bbv[8]; float cr[16], ci[16]; };
__device__ __forceinline__ void p5_sample_ssm_load(Frame& F, int sb, int g, SsmLd& L) {
    const int p = F.lane;
    const float* sp = (const float*)(F.ws + WS_SSMP);
    L.ar = sp[SSMP_A1 / 4 + (g * 64 + p) * 2]; L.ai = sp[SSMP_A1 / 4 + (g * 64 + p) * 2 + 1];
    L.h0r = FIN(2)[(size_t)(sb * 64 + g) * 64 + p]; L.h0i = FIN(3)[(size_t)(sb * 64 + g) * 64 + p];
    L.uval = ((const float*)(F.ws + WS_US))[(size_t)sb * DM + g * 16 + (p & 15)];
    L.dsk = FIN(19)[g * 16 + (p & 15)];
#pragma unroll
    for (int c = 0; c < 8; ++c) L.bbv[c] = *(const GAS f32x4*)(sp + SSMP_BB / 4 + (size_t)(g * 64 + p) * 32 + 4 * c);
#pragma unroll
    for (int co = 0; co < 16; ++co) { L.cr[co] = FIN(17)[(size_t)(g * 16 + co) * 64 + p]; L.ci[co] = FIN(18)[(size_t)(g * 16 + co) * 64 + p]; }
}
__device__ __forceinline__ void p5_sample_ssm_step(Frame& F, int sb, int g, const SsmLd& L) {
    const int p = F.lane;
    float bur = 0.f, bui = 0.f;
#pragma unroll
    for (int c = 0; c < 16; ++c) { const float uc = __shfl(L.uval, c); bur += L.bbv[c >> 1][(c & 1) * 2] * uc; bui += L.bbv[c >> 1][(c & 1) * 2 + 1] * uc; }
    const float hr = L.ar * L.h0r - L.ai * L.h0i + bur, hi = L.ar * L.h0i + L.ai * L.h0r + bui;
    F.out[O_SSR + (size_t)(sb * 64 + g) * 64 + p] = hr; F.out[O_SSI + (size_t)(sb * 64 + g) * 64 + p] = hi;
    float yv = 0.f;
#pragma unroll
    for (int co = 0; co < 16; ++co) { const float t = wave_sum(L.cr[co] * hr - L.ci[co] * hi); if (p == co) yv = t; }
    if (p < 16) { const float y = yv + L.dsk * L.uval; ((bf16*)(F.ws + WS_YSM))[(size_t)(MPR + sb) * DM + g * 16 + p] = (bf16)f2bf(gelu_tanh(y)); }
}
__device__ __forceinline__ void p5_sample_ssm(Frame& F, int sb, int g) { SsmLd L; p5_sample_ssm_load(F, sb, g, L); p5_sample_ssm_step(F, sb, g, L); }

struct Sched2 { ge::StdSched a, b; int na;
    __device__ __forceinline__ bool seg(int i, ge::Seg& s) const { if (i < na) return a.seg(i, s); if (!b.seg(i - na, s)) return false; s.geo = 1; return true; } };
template <class EA, class EB> struct Epi2 { EA e0; EB e1;
    template <int AI_N = 2, int M_N = 4> __device__ __forceinline__ void run(const AccT& acc, const ge::Seg& u, int wr, int wc, int fr, int fq) const {
        if (u.geo == 0) e0.template run<AI_N, M_N>(acc, u, wr, wc, fr, fq); else e1.template run<AI_N, M_N>(acc, u, wr, wc, fr, fq); } };

constexpr int N_PHASES = 12;
__global__ void __launch_bounds__(NWAVES * 64, 2) fwd_kernel(Args args) {
    extern __shared__ __attribute__((aligned(16))) unsigned char lds_raw[];
    Frame F;
    F.lds = (LAS unsigned char*)lds_raw;
    F.tid = threadIdx.x; F.lane = F.tid & 63; F.wave = __builtin_amdgcn_readfirstlane(F.tid >> 6);
    F.G = gridDim.x; F.bid = blockIdx.x;
    F.a = &args; F.out = args.out; F.ws = args.ws;
    volatile LAS unsigned* MISC = (volatile LAS unsigned*)(F.lds + MISC_OFF);
    for (int u = F.tid; u < (LDS_BYTES - LDSCTL_OFF) / 4; u += NWAVES * 64) ((LAS unsigned*)(F.lds + LDSCTL_OFF))[u] = 0u;
    __syncthreads();
    const int lo = args.ph_lo, hi = args.ph_hi;
    const bool use_bar = (hi - lo) > 1;
    XcdBarrier bar; bar.bar = (unsigned*)(F.ws + WS_CTL) + CW_BAR; bar.x = 0; bar.st = nullptr;
    if (use_bar) bar = xcd_barrier_post((unsigned*)(F.ws + WS_CTL) + CW_BAR, MISC + 8);
#ifdef ONLY_PHASE
#define IN(k) ((k) == ONLY_PHASE)
#else
#define IN(k) (lo <= (k) && (k) < hi)
#endif
#define SEAM(k) do { if (IN(k) && IN((k) + 1)) xcd_barrier(bar); } while (0)
    bf16* XBF = (bf16*)(F.ws + WS_XBF); float* SSP = (float*)(F.ws + WS_SSP); bf16* HID = (bf16*)(F.ws + WS_HID);

    if (IN(0)) { p0_prologue(F); } SEAM(0);
    if (IN(1)) {
        ge::StdSched S; S.init(XBF, DM * 2, F.ws + WS_WGU1, DM * 2, MPR, 2 * FF, DM, F.G, F.bid);
        fill_rstd(F, S, (const float*)(F.ws + WS_SS0), 1);
        const __amdgpu_buffer_rsrc_t hsr = __builtin_amdgcn_make_buffer_rsrc((void*)HID, (short)0, (int)((size_t)MP * FF * 2), 0x00020000);
        EpiGateUp E{(const LAS float*)(F.lds + RSTAB_OFF), HID, hsr}, Es{(const LAS float*)(F.lds + RSTAB_S_OFF), HID, hsr}; const ge::GeoDesc gd[1] = {{DM * 2, DM * 2, 0}};
        skinny_phase<false>(F, XBF, DM, F.ws + WS_WGU1, DM, 2 * FF, DM, Es);
        ge::gemm_phase<EpiGateUp, ge::StdSched, 1>(F.lds, S, E, gd);
        if (F.G == 256 && F.bid >= 128) { bg_copy(F, BGO_P1 + (F.bid - 128) * BGW_T1, BGO_P1 + (F.bid - 127) * BGW_T1, F.wave, NWAVES);
            p0_weights(F, P0_NITEMS - P0_LATE, P0_NITEMS, (F.bid - 128) * NWAVES + F.wave, 128 * NWAVES); }
    } SEAM(1);
    if (IN(2)) {
        ge::StdSched S; S.init(HID, FF * 2, F.ws + WS_WD1, FF * 2, MPR, DM, FF, F.G, F.bid);
        EpiResid<false> E{0.5f, XBF, SSP, nullptr, (float*)(F.ws + WS_SSPS)}; const ge::GeoDesc gd[1] = {{FF * 2, FF * 2, 0}};
        skinny_phase<true>(F, HID, FF, F.ws + WS_WD1, FF, DM, FF, E);
        if (F.G == 256 && F.bid < BG_NF) bg_copy(F, BGO_S2 + F.bid * BGW_S2, BGO_S2 + (F.bid + 1) * BGW_S2, F.wave, NWAVES);
        ge::gemm_phase<EpiResid<false>, ge::StdSched, 1>(F.lds, S, E, gd);
    } SEAM(2);
    if (IN(3)) {
        ge::StdSched S; S.init(XBF, DM * 2, F.ws + WS_WIN, DM * 2, MPR, NIN, DM, F.G, F.bid);
        fill_rstd(F, S, SSP, 16);
        EpiWin E{(const LAS float*)(F.lds + RSTAB_OFF), (bf16*)(F.ws + WS_U), (bf16*)(F.ws + WS_Q), (bf16*)(F.ws + WS_K), (bf16*)(F.ws + WS_V), (bf16*)(F.ws + WS_GA), (bf16*)(F.ws + WS_GB),
                 (float*)(F.ws + WS_US), FIN(22), FIN(23), F.out};
        EpiWin Es = E; Es.rs = (const LAS float*)(F.lds + RSTAB_S_OFF);
        const ge::GeoDesc gd[1] = {{DM * 2, DM * 2, 0}};
        skinny_phase<false>(F, XBF, DM, F.ws + WS_WIN, DM, NIN, DM, Es);
        ge::gemm_phase<EpiWin, ge::StdSched, 1>(F.lds, S, E, gd);
        if (F.G == 256 && F.bid >= 64) bg_copy(F, BGO_P3 + (F.bid - 64) * BGW_T, BGO_P3 + (F.bid - 63) * BGW_T, F.wave, NWAVES);
    } SEAM(3);
    const bool px = (F.G == 256) && IN(4) && IN(5) && IN(6);
    if (px) {
        if (F.bid < 128) {
            const int g = F.bid >> 1, pm = F.bid & 1;
            { StateSched S{(const char*)(F.ws + WS_U), (const char*)(F.ws + WS_W1T), F.G, F.bid}; EpiStateLds E{};
              const ge::GeoDesc gd[1] = {{1024, 1024, 0, 1}};
              ge::gemm_phase<EpiStateLds, StateSched, 1, true>(F.lds, S, E, gd); }
            __syncthreads();
            if (F.wave < 2) p5_carry_lds(F, g, 2 * pm + F.wave, F.wave);
            else if (F.wave < 5) attn_sample_task(F, F.bid * 3 + (F.wave - 2), RSTAB_OFF + (F.wave - 2) * 1024);
            else {
                for (int q = F.wave - 5; q < 8; q += 6) { const int t0 = F.bid * 8 + q, t1 = t0 + 3; const bool two = q + 3 < 8;
                    SsmLd L0, L1; p5_sample_ssm_load(F, t0 >> 6, t0 & 63, L0); p5_sample_ssm_load(F, two ? t1 >> 6 : t0 >> 6, two ? t1 & 63 : t0 & 63, L1);
                    p5_sample_ssm_step(F, t0 >> 6, t0 & 63, L0); if (two) p5_sample_ssm_step(F, t1 >> 6, t1 & 63, L1); } }
            VM_WAIT(); __syncthreads();
            { SsmYSchedB S{(const char*)(F.ws + WS_HS), (const char*)(F.ws + WS_BH), (const char*)(F.ws + WS_U), (const char*)(F.ws + WS_KT), F.bid};
              EpiSsmY E{(bf16*)(F.ws + WS_YSM)};
              const ge::GeoDesc gd[2] = {{256, 256, 0}, {1024, 0, 1}};
              ge::gemm_phase<EpiSsmY, SsmYSchedB, 2>(F.lds, S, E, gd); }
        } else {
            {
                unsigned* ctr = (unsigned*)(F.ws + WS_CTL) + CW_DYN + 64 * (F.bid & 7); volatile LAS int* NXW = (volatile LAS int*)(F.lds + MISC_OFF) + 20;
                AttPre P; int cur = F.bid - 128; attn_pre_load(F, cur, P);
                while (cur < 768) cur = attn_item_pipe(F, cur, ctr, NXW, P);
                __syncthreads();
            }
            { const int t0 = 1024 + (F.bid - 128) * NWAVES + F.wave; SsmLd L0; p5_sample_ssm_load(F, t0 >> 6, t0 & 63, L0);
              bg_copy(F, BGO_XA + (F.bid - 128) * BGW_XA, BGO_XA + (F.bid - 127) * BGW_XA, F.wave, NWAVES);
              p5_sample_ssm_step(F, t0 >> 6, t0 & 63, L0); }
        }
    } else {
    if (IN(4)) {
        { StateSched S{(const char*)(F.ws + WS_U), (const char*)(F.ws + WS_W1T), F.G, F.bid}; EpiState E{(float*)(F.ws + WS_SST)};
          const ge::GeoDesc gd[1] = {{1024, 1024, 0}};
          ge::gemm_phase<EpiState, StateSched, 1>(F.lds, S, E, gd); }
        __syncthreads();
        for (int it = F.bid; it < 768; it += F.G) attn_item(F, it);
    } SEAM(4);
    if (IN(5)) {
        for (int t = F.bid * NWAVES + F.wave; t < NSMP * NG; t += F.G * NWAVES) p5_sample_ssm(F, t >> 6, t & 63);
        if (F.wave == 0) for (int u = F.bid; u < 256; u += F.G) p5_carry(F, u >> 2, u & 3);
        if (F.wave == 1 || F.wave == 2) for (int t = (F.wave - 1) * F.G + F.bid; t < NSMP * 4 * 3; t += 2 * F.G) attn_sample_task(F, t, F.wave * 2048);
        if (F.G == 256 && F.wave >= 3) { if (F.bid < 128) bg_copy(F, BGO_XS + F.bid * BGW_XS, BGO_XS + (F.bid + 1) * BGW_XS, F.wave - 3, NWAVES - 3);
                                         else bg_copy(F, BGO_XA + (F.bid - 128) * BGW_XA, BGO_XA + (F.bid - 127) * BGW_XA, F.wave - 3, NWAVES - 3); }
    } SEAM(5);
    if (IN(6)) {
        SsmYSched S{(const char*)(F.ws + WS_HS), (const char*)(F.ws + WS_BH), (const char*)(F.ws + WS_U), (const char*)(F.ws + WS_KT), F.G, F.bid};
        EpiSsmY E{(bf16*)(F.ws + WS_YSM)};
        const ge::GeoDesc gd[2] = {{256, 256, 0}, {1024, 0, 1}};
        ge::gemm_phase<EpiSsmY, SsmYSched, 2>(F.lds, S, E, gd);
    }
    }
    SEAM(6);
    if (IN(7)) {
        p5_combine(F); sample_mix(F);
        ge::StdSched S; S.init(F.ws + WS_YSM, DM * 2, F.ws + WS_WGLU, DM * 2, MPR, DM, DM, F.G, F.bid);
        EpiElem<0> E{(const bf16*)(F.ws + WS_YSM), nullptr, (bf16*)(F.ws + WS_YA)}; const ge::GeoDesc gd[1] = {{DM * 2, DM * 2, 0}};
        skinny_phase<true>(F, F.ws + WS_YSM, DM, F.ws + WS_WGLU, DM, DM, DM, E);
        if (F.G == 256 && F.bid < BG_NF) bg_copy(F, BGO_S7 + F.bid * BGW_S7, BGO_S7 + (F.bid + 1) * BGW_S7, F.wave, NWAVES);
        ge::gemm_phase<EpiElem<0>, ge::StdSched, 1>(F.lds, S, E, gd);
    } SEAM(7);
    if (IN(8)) {
        ge::StdSched S0; S0.init(F.ws + WS_OB, SW * 2, F.ws + WS_WPB, SW * 2, MPR, DM, SW, F.G, F.bid);
        ge::StdSched S1; S1.init(F.ws + WS_YA, DM * 2, F.ws + WS_WPA, DM * 2, MPR, DM, DM, F.G, F.bid);
        EpiElem<1> E0{(const bf16*)(F.ws + WS_GB), nullptr, (bf16*)(F.ws + WS_TB)};
        EpiElem<2> E1{(const bf16*)(F.ws + WS_GA), (const bf16*)(F.ws + WS_TB), (bf16*)(F.ws + WS_YSM)};
        for (int j = F.G - 1 - F.bid; j < DM / 32; j += F.G)
            skinny_merge_unit(F.lds, (const bf16*)(F.ws + WS_YA), (const bf16*)(F.ws + WS_WPA), (const bf16*)(F.ws + WS_OB), (const bf16*)(F.ws + WS_WPB),
                              (const bf16*)(F.ws + WS_GA), (const bf16*)(F.ws + WS_GB), (bf16*)(F.ws + WS_YSM), j >> 3, (j >> 1) & 3, j & 1);
        if (F.G == 256 && F.bid < BG_NF) bg_copy(F, BGO_S8 + F.bid * BGW_S8, BGO_S8 + (F.bid + 1) * BGW_S8, F.wave, NWAVES);
        int na = 0; { ge::Seg t; while (S0.seg(na, t)) ++na; }
        Sched2 S{S0, S1, na}; Epi2<EpiElem<1>, EpiElem<2> > E{E0, E1};
        const ge::GeoDesc gd[2] = {{SW * 2, SW * 2, 0}, {DM * 2, DM * 2, 0}};
        ge::gemm_phase<Epi2<EpiElem<1>, EpiElem<2> >, Sched2, 2>(F.lds, S, E, gd);
    } SEAM(8);
    if (IN(9)) {
        ge::StdSched S; S.init(F.ws + WS_YSM, DM * 2, F.ws + WS_WOUT, DM * 2, MPR, DM, DM, F.G, F.bid);
        EpiResid<false> E{1.0f, XBF, SSP, nullptr, (float*)(F.ws + WS_SSPS)}; const ge::GeoDesc gd[1] = {{DM * 2, DM * 2, 0}};
        skinny_phase<true>(F, F.ws + WS_YSM, DM, F.ws + WS_WOUT, DM, DM, DM, E);
        if (F.G == 256 && F.bid < BG_NF) bg_copy(F, BGO_S9 + F.bid * BGW_S9, BGO_S9 + (F.bid + 1) * BGW_S9, F.wave, NWAVES);
        ge::gemm_phase<EpiResid<false>, ge::StdSched, 1>(F.lds, S, E, gd);
    } SEAM(9);
    if (IN(10)) {
        ge::StdSched S; S.init(XBF, DM * 2, F.ws + WS_WGU2, DM * 2, MPR, 2 * FF, DM, F.G, F.bid);
        fill_rstd(F, S, SSP, 16);
        const __amdgpu_buffer_rsrc_t hsr = __builtin_amdgcn_make_buffer_rsrc((void*)HID, (short)0, (int)((size_t)MP * FF * 2), 0x00020000);
        EpiGateUp E{(const LAS float*)(F.lds + RSTAB_OFF), HID, hsr}, Es{(const LAS float*)(F.lds + RSTAB_S_OFF), HID, hsr}; const ge::GeoDesc gd[1] = {{DM * 2, DM * 2, 0}};
        skinny_phase<false>(F, XBF, DM, F.ws + WS_WGU2, DM, 2 * FF, DM, Es);
        ge::gemm_phase<EpiGateUp, ge::StdSched, 1>(F.lds, S, E, gd);
        if (F.G == 256 && F.bid >= 128) bg_copy(F, BGO_P10 + (F.bid - 128) * BGW_T10, BGO_P10 + (F.bid - 127) * BGW_T10, F.wave, NWAVES);
    } SEAM(10);
    if (IN(11)) {
        ge::StdSched S; S.init(HID, FF * 2, F.ws + WS_WD2, FF * 2, MPR, DM, FF, F.G, F.bid);
        EpiResid<true> E{0.5f, XBF, nullptr, F.out, nullptr}; const ge::GeoDesc gd[1] = {{FF * 2, FF * 2, 0}};
        skinny_phase<true>(F, HID, FF, F.ws + WS_WD2, FF, DM, FF, E);
        if (F.G == 256 && F.bid < BG_NF) bg_copy(F, BGO_S11 + F.bid * BGW_S11, BGO_S11 + (F.bid + 1) * BGW_S11, F.wave, NWAVES);
        ge::gemm_phase<EpiResid<true>, ge::StdSched, 1>(F.lds, S, E, gd);
    }
#undef IN
#undef SEAM
}

#ifndef DBG_LAST_PHASE
#define DBG_LAST_PHASE 11
#endif
#ifndef MK_N_LAUNCHES
#define MK_N_LAUNCHES 1
#endif
extern "C" void kernel_launch(void* const* d_in, const int* in_sizes, int n_in, void* d_out, int out_size, void* d_ws, size_t ws_size, hipStream_t stream) {
    static int grid = 0;
    if (grid == 0) {
        if (n_in != 31 || (size_t)out_size != O_END || ws_size < WS_END) { fprintf(stderr, "kernel_launch: unexpected sizes: n_in %d out %d (want %zu) ws %zu (want >= %zu)\n", n_in, out_size, (size_t)O_END, ws_size, (size_t)WS_END); grid = -1; return; }
        int dev = 0, cus = 0, per_cu = 0;
        if (hipGetDevice(&dev) != hipSuccess || hipDeviceGetAttribute(&cus, hipDeviceAttributeMultiprocessorCount, dev) != hipSuccess) { grid = -1; return; }
        if (hipFuncSetAttribute((const void*)fwd_kernel, hipFuncAttributeMaxDynamicSharedMemorySize, LDS_BYTES) != hipSuccess) { fprintf(stderr, "kernel_launch: hipFuncSetAttribute failed\n"); grid = -1; return; }
        if (hipOccupancyMaxActiveBlocksPerMultiprocessor(&per_cu, (const void*)fwd_kernel, NWAVES * 64, LDS_BYTES) != hipSuccess || per_cu < 1) { fprintf(stderr, "kernel_launch: occupancy query says %d\n", per_cu); per_cu = 1; }
        (void)hipGetLastError();
        grid = cus;
    }
    if (grid < 0) return;
    (void)hipMemsetAsync((char*)d_ws + WS_CTL, 0, CTL_ZERO_BYTES, stream);
    Args a{};
    for (int i = 0; i < 31; ++i) a.in[i] = (const float*)d_in[i];
    a.out = (float*)d_out; a.ws = (unsigned char*)d_ws;
    if (MK_N_LAUNCHES == 1) { a.ph_lo = 0; a.ph_hi = N_PHASES; hipLaunchKernelGGL(fwd_kernel, dim3(grid), dim3(NWAVES * 64), LDS_BYTES, stream, a); }
    else for (int p = 0; p < DBG_LAST_PHASE + 1; ++p) { a.ph_lo = p; a.ph_hi = p + 1; hipLaunchKernelGGL(fwd_kernel, dim3(grid), dim3(NWAVES * 64), LDS_BYTES, stream, a); }
}
```
